# Optimizing an MI355X kernel written in HIP

```python
import math
import numpy as np
import jax
import jax.numpy as jnp
from jax import lax

D_MODEL = 2048
BATCH = 2
SEQ = 8192
DEPTH = 4

PLE_DIM = 256
D_FF = 5632
HALF_STEP = 0.5
NORM_EPS = 1e-6
CHUNK = 128
N_BRANCH = 3
A_HEADS = 4
A_QK = 128
A_V = 256
B_HEADS = 16
B_HEADDIM = 64
B_INNER = B_HEADS * B_HEADDIM
B_STATE = 128
B_GROUPS = 2
CONV_K = 5
DT_MIN = 1e-3
DT_MAX = 1e-1
C_HEADS = 8
C_Q_RANK = 512
C_KV_RANK = 512
C_NOPE = 128
C_ROPE = 64
C_V = 128
ROPE_THETA = 10000.0
MAX_POS_OFFSET = 1024

BRANCH_W = 1024
A_QK_W = A_HEADS * A_QK
A_V_W = A_HEADS * A_V
B_XBC_W = B_INNER + 2 * B_GROUPS * B_STATE
IN_SPLITS = (A_QK_W, A_QK_W, A_V_W, A_V_W, 2 * A_HEADS, 2 * A_HEADS,
             B_INNER, B_XBC_W, 2 * B_HEADS,
             C_Q_RANK, C_KV_RANK, C_ROPE,
             N_BRANCH * D_MODEL)
D_IN = sum(IN_SPLITS)

kernel_name = "hybrid_mlstm_ssd_mla_macaron_encoder"


def rmsnorm(x, g):
    xf = x.astype(jnp.float32)
    y = xf * lax.rsqrt(jnp.mean(xf * xf, axis=-1, keepdims=True) + NORM_EPS)
    return (y * g.astype(jnp.float32)).astype(x.dtype)


def swiglu(x, w13, w2):
    a, b = jnp.split(x @ w13, 2, axis=-1)
    return (jax.nn.silu(a) * b) @ w2


def split_cols(t, sizes):
    idx = [int(v) for v in np.cumsum(sizes)[:-1]]
    return jnp.split(t, idx, axis=-1)


def mlstm_chunkwise(q, k, v, li, lf):
    bsz, nh, seq, dk = q.shape
    dv = v.shape[-1]
    nc = seq // CHUNK
    q = q.reshape(bsz, nh, nc, CHUNK, dk)
    k = k.reshape(bsz, nh, nc, CHUNK, dk)
    v = v.reshape(bsz, nh, nc, CHUNK, dv)
    li = li.reshape(bsz, nh, nc, CHUNK)
    lf = lf.reshape(bsz, nh, nc, CHUNK)
    b = jnp.cumsum(lf, axis=-1)
    g = b[..., -1]
    w_state = g[..., None] - b + li
    m_loc = jnp.max(w_state, axis=-1)
    e_state = jnp.exp(w_state - m_loc[..., None])
    c_loc = jnp.einsum('bhcsk,bhcsv->bhckv', k * e_state[..., None], v)
    n_loc = jnp.einsum('bhcs,bhcsk->bhck', e_state, k)

    def step(carry, inp):
        c_st, n_st, m_st = carry
        c_l, n_l, m_l, g_c = inp
        m_new = jnp.maximum(g_c + m_st, m_l)
        a_prev = jnp.exp(g_c + m_st - m_new)
        a_loc = jnp.exp(m_l - m_new)
        c_new = a_prev[..., None, None] * c_st + a_loc[..., None, None] * c_l
        n_new = a_prev[..., None] * n_st + a_loc[..., None] * n_l
        return (c_new, n_new, m_new), (c_st, n_st, m_st)

    init = (jnp.zeros((bsz, nh, dk, dv), jnp.float32),
            jnp.zeros((bsz, nh, dk), jnp.float32),
            jnp.zeros((bsz, nh), jnp.float32))
    xs = (jnp.moveaxis(c_loc, 2, 0), jnp.moveaxis(n_loc, 2, 0),
          jnp.moveaxis(m_loc, 2, 0), jnp.moveaxis(g, 2, 0))
    _, (c0, n0, m0) = lax.scan(step, init, xs)
    c0 = jnp.moveaxis(c0, 0, 2)
    n0 = jnp.moveaxis(n0, 0, 2)
    m0 = jnp.moveaxis(m0, 0, 2)

    causal = jnp.tril(jnp.ones((CHUNK, CHUNK), dtype=bool))
    log_d = b[..., :, None] - b[..., None, :] + li[..., None, :]
    log_d = jnp.where(causal, log_d, -jnp.inf)
    log_inter = b + m0[..., None]
    m_t = jnp.maximum(log_inter, jnp.max(log_d, axis=-1))
    s_qk = jnp.einsum('bhctk,bhcsk->bhcts', q, k) * jnp.exp(log_d - m_t[..., None])
    e_inter = jnp.exp(log_inter - m_t)
    num = (jnp.einsum('bhcts,bhcsv->bhctv', s_qk, v)
           + e_inter[..., None] * jnp.einsum('bhctk,bhckv->bhctv', q, c0))
    den = jnp.sum(s_qk, axis=-1) + e_inter * jnp.einsum('bhctk,bhck->bhct', q, n0)
    h = num / jnp.maximum(jnp.abs(den), jnp.exp(-m_t))[..., None]
    return h.reshape(bsz, nh, seq, dv)


def mlstm_branch(q, k, v, o, ig, fg, b_ig, b_fg, norm_g):
    bsz, seq, _ = q.shape
    f32 = jnp.float32

    def heads(t, d):
        return t.astype(f32).reshape(bsz, seq, A_HEADS, d).transpose(0, 2, 1, 3)

    qh = heads(q, A_QK)
    kh = heads(k, A_QK) * (A_QK ** -0.5)
    vh = heads(v, A_V)
    li = (ig.astype(f32).reshape(bsz, seq, 2, A_HEADS) + b_ig.astype(f32)).transpose(0, 2, 3, 1)
    lf = jax.nn.log_sigmoid(fg.astype(f32).reshape(bsz, seq, 2, A_HEADS) + b_fg.astype(f32)).transpose(0, 2, 3, 1)
    flip = lambda t: jnp.flip(t, axis=2)
    h_fwd = mlstm_chunkwise(qh, kh, vh, li[:, 0], lf[:, 0])
    h_bwd = flip(mlstm_chunkwise(flip(qh), flip(kh), flip(vh), flip(li[:, 1]), flip(lf[:, 1])))
    h = (h_fwd + h_bwd).transpose(0, 2, 1, 3)
    h = h * lax.rsqrt(jnp.mean(h * h, axis=-1, keepdims=True) + NORM_EPS)
    h = h.reshape(bsz, seq, A_V_W) * norm_g.astype(f32)
    return (jax.nn.sigmoid(o.astype(f32)) * h).astype(q.dtype)


def centred_dwconv(x, w, b):
    pad = (CONV_K - 1) // 2
    y = lax.conv_general_dilated(x, w[:, None, :], window_strides=(1,), padding=[(pad, pad)],
                                 dimension_numbers=('NWC', 'WIO', 'NWC'),
                                 feature_group_count=x.shape[-1])
    return y + b


def ssd_chunked(x, dt, a, bm, cm):
    bsz, seq, nh, hp = x.shape
    ng, ns = bm.shape[2], bm.shape[3]
    ne = nh // ng
    nc = seq // CHUNK
    x = x.reshape(bsz, nc, CHUNK, ng, ne, hp)
    dt = dt.reshape(bsz, nc, CHUNK, ng, ne)
    bm = bm.reshape(bsz, nc, CHUNK, ng, ns)
    cm = cm.reshape(bsz, nc, CHUNK, ng, ns)
    acs = jnp.cumsum(dt * a.reshape(ng, ne), axis=2)
    xdt = x * dt[..., None]
    causal = jnp.tril(jnp.ones((CHUNK, CHUNK), dtype=bool))[:, :, None, None]
    seg = acs[:, :, :, None] - acs[:, :, None, :]
    decay = jnp.exp(jnp.where(causal, seg, -jnp.inf))
    cb = jnp.einsum('bctgn,bcsgn->bctsg', cm, bm)
    y_diag = jnp.einsum('bctsge,bcsgep->bctgep', cb[..., None] * decay, xdt)
    decay_to_end = jnp.exp(acs[:, :, -1:] - acs)
    states = jnp.einsum('bcsgn,bcsgep->bcgenp', bm, xdt * decay_to_end[..., None])
    chunk_decay = jnp.exp(acs[:, :, -1])

    def step(s, inp):
        st, dc = inp
        return dc[..., None, None] * s + st, s

    init = jnp.zeros((bsz, ng, ne, ns, hp), jnp.float32)
    _, s0 = lax.scan(step, init, (jnp.moveaxis(states, 1, 0), jnp.moveaxis(chunk_decay, 1, 0)))
    s0 = jnp.moveaxis(s0, 0, 1)
    y_off = jnp.einsum('bctgn,bcgenp->bctgep', cm, s0) * jnp.exp(acs)[..., None]
    return (y_diag + y_off).reshape(bsz, seq, nh, hp)


def mamba2_branch(z, xbc, dt_raw, conv_w, conv_b, a_log, dt_bias, d_skip, norm_g):
    bsz, seq, _ = z.shape
    f32 = jnp.float32
    xbc = jax.nn.silu(centred_dwconv(xbc, conv_w, conv_b)).astype(f32)
    xs, bm, cm = split_cols(xbc, (B_INNER, B_GROUPS * B_STATE, B_GROUPS * B_STATE))
    xh = xs.reshape(bsz, seq, B_HEADS, B_HEADDIM)
    bm = bm.reshape(bsz, seq, B_GROUPS, B_STATE)
    cm = cm.reshape(bsz, seq, B_GROUPS, B_STATE)
    dt = jax.nn.softplus(dt_raw.astype(f32).reshape(bsz, seq, 2, B_HEADS) + dt_bias.astype(f32))
    a = -jnp.exp(a_log.astype(f32))
    flip = lambda t: jnp.flip(t, axis=1)
    y_f = ssd_chunked(xh, dt[:, :, 0], a[0], bm, cm)
    y_b = flip(ssd_chunked(flip(xh), flip(dt[:, :, 1]), a[1], flip(bm), flip(cm)))
    y = y_f + y_b + d_skip.astype(f32)[:, None] * xh
    y = y.reshape(bsz, seq, B_INNER) * jax.nn.silu(z.astype(f32))
    return rmsnorm(y, norm_g).astype(z.dtype)


def apply_rope(t, positions):
    half = C_ROPE // 2
    inv_freq = ROPE_THETA ** (-jnp.arange(half, dtype=jnp.float32) / half)
    ang = positions.astype(jnp.float32)[:, :, None, None] * inv_freq
    cos, sin = jnp.cos(ang), jnp.sin(ang)
    tf = t.astype(jnp.float32)
    t1, t2 = tf[..., :half], tf[..., half:]
    return jnp.concatenate([t1 * cos - t2 * sin, t2 * cos + t1 * sin], axis=-1).astype(t.dtype)


def mla_branch(c_q, c_kv, k_rope, positions, q_norm, kv_norm, w_uq, w_ukv):
    bsz, seq, _ = c_q.shape
    dqk = C_NOPE + C_ROPE
    q = (rmsnorm(c_q, q_norm) @ w_uq).reshape(bsz, seq, C_HEADS, dqk)
    kv = (rmsnorm(c_kv, kv_norm) @ w_ukv).reshape(bsz, seq, C_HEADS, C_NOPE + C_V)
    q_nope, q_rot = q[..., :C_NOPE], q[..., C_NOPE:]
    k_nope, v = kv[..., :C_NOPE], kv[..., C_NOPE:]
    q_rot = apply_rope(q_rot, positions)
    k_rot = jnp.broadcast_to(apply_rope(k_rope[:, :, None, :], positions), (bsz, seq, C_HEADS, C_ROPE))
    q = jnp.concatenate([q_nope, q_rot], axis=-1) * (dqk ** -0.5)
    k = jnp.concatenate([k_nope, k_rot], axis=-1)
    nb = seq // CHUNK
    qb = q.reshape(bsz, nb, CHUNK, C_HEADS, dqk).transpose(1, 0, 2, 3, 4)

    def attend(q_blk):
        s = jnp.einsum('blhd,bshd->bhls', q_blk, k).astype(jnp.float32)
        pr = jax.nn.softmax(s, axis=-1).astype(v.dtype)
        return jnp.einsum('bhls,bshd->blhd', pr, v)

    o = lax.map(attend, qb)
    return o.transpose(1, 0, 2, 3, 4).reshape(bsz, seq, C_HEADS * C_V)


def setup_inputs(seed: int = 0) -> dict:
    key = jax.random.key(seed)
    keys = iter(jax.random.split(key, 48))
    f32 = jnp.float32
    L, D = DEPTH, D_MODEL

    def nrm(shape, scale):
        return jax.random.normal(next(keys), shape, f32) * scale

    def gain(shape):
        return 1.0 + 0.1 * jax.random.normal(next(keys), shape, f32)

    x = nrm((BATCH, SEQ, D), 1.0)
    p = nrm((DEPTH, BATCH, SEQ, PLE_DIM), 1.0)
    positions = (jnp.arange(SEQ, dtype=jnp.int32)[None, :]
                 + jax.random.randint(next(keys), (BATCH, 1), 0, MAX_POS_OFFSET, dtype=jnp.int32))
    ffn1_norm = gain((L, D))
    ffn1_w13 = nrm((L, D, 2 * D_FF), D ** -0.5)
    ffn1_w2 = nrm((L, D_FF, D), D_FF ** -0.5)
    mix_norm = gain((L, D))
    w_in = nrm((L, D, D_IN), D ** -0.5)
    mlstm_b_igate = nrm((L, 2, A_HEADS), 0.1)
    mlstm_b_fgate = jax.random.uniform(next(keys), (L, 2, A_HEADS), f32, 3.0, 6.0)
    mlstm_norm = gain((L, A_V_W))
    conv_w = nrm((L, CONV_K, B_XBC_W), CONV_K ** -0.5)
    conv_b = nrm((L, B_XBC_W), 0.01)
    ssm_a_log = jnp.log(jax.random.uniform(next(keys), (L, 2, B_HEADS), f32, 1.0, 16.0))
    dt0 = jnp.exp(jax.random.uniform(next(keys), (L, 2, B_HEADS), f32, math.log(DT_MIN), math.log(DT_MAX)))
    ssm_dt_bias = dt0 + jnp.log(-jnp.expm1(-dt0))
    ssm_d = gain((L, B_HEADS))
    ssm_norm = gain((L, B_INNER))
    mla_q_norm = gain((L, C_Q_RANK))
    mla_kv_norm = gain((L, C_KV_RANK))
    mla_w_uq = nrm((L, C_Q_RANK, C_HEADS * (C_NOPE + C_ROPE)), C_Q_RANK ** -0.5)
    mla_w_ukv = nrm((L, C_KV_RANK, C_HEADS * (C_NOPE + C_V)), C_KV_RANK ** -0.5)
    w_branch = nrm((L, N_BRANCH, BRANCH_W, D), BRANCH_W ** -0.5)
    w_out = nrm((L, D, D), D ** -0.5)
    ffn2_norm = gain((L, D))
    ffn2_w13 = nrm((L, D, 2 * D_FF), D ** -0.5)
    ffn2_w2 = nrm((L, D_FF, D), D_FF ** -0.5)
    ple_norm = gain((L, D))
    w_ple_gate = nrm((L, D, D), D ** -0.5)
    w_ple_proj = nrm((L, PLE_DIM, D), PLE_DIM ** -0.5)
    final_norm = gain((D,))
    return {"x": x, "p": p, "positions": positions,
            "ffn1_norm": ffn1_norm, "ffn1_w13": ffn1_w13, "ffn1_w2": ffn1_w2,
            "mix_norm": mix_norm, "w_in": w_in,
            "mlstm_b_igate": mlstm_b_igate, "mlstm_b_fgate": mlstm_b_fgate, "mlstm_norm": mlstm_norm,
            "conv_w": conv_w, "conv_b": conv_b, "ssm_a_log": ssm_a_log, "ssm_dt_bias": ssm_dt_bias,
            "ssm_d": ssm_d, "ssm_norm": ssm_norm,
            "mla_q_norm": mla_q_norm, "mla_kv_norm": mla_kv_norm, "mla_w_uq": mla_w_uq, "mla_w_ukv": mla_w_ukv,
            "w_branch": w_branch, "w_out": w_out,
            "ffn2_norm": ffn2_norm, "ffn2_w13": ffn2_w13, "ffn2_w2": ffn2_w2,
            "ple_norm": ple_norm, "w_ple_gate": w_ple_gate, "w_ple_proj": w_ple_proj,
            "final_norm": final_norm}


def reference(x, p, positions, ffn1_norm, ffn1_w13, ffn1_w2, mix_norm, w_in,
              mlstm_b_igate, mlstm_b_fgate, mlstm_norm, conv_w, conv_b,
              ssm_a_log, ssm_dt_bias, ssm_d, ssm_norm,
              mla_q_norm, mla_kv_norm, mla_w_uq, mla_w_ukv,
              w_branch, w_out, ffn2_norm, ffn2_w13, ffn2_w2,
              ple_norm, w_ple_gate, w_ple_proj, final_norm):
    bsz, seq, _ = x.shape
    h = x
    for i in range(DEPTH):
        h = h + HALF_STEP * swiglu(rmsnorm(h, ffn1_norm[i]), ffn1_w13[i], ffn1_w2[i])
        u = rmsnorm(h, mix_norm[i])
        (a_q, a_k, a_v, a_o, a_ig, a_fg, b_z, b_xbc, b_dt,
         c_q, c_kv, c_kr, gate_pre) = split_cols(u @ w_in[i], IN_SPLITS)
        y_a = mlstm_branch(a_q, a_k, a_v, a_o, a_ig, a_fg,
                           mlstm_b_igate[i], mlstm_b_fgate[i], mlstm_norm[i]) @ w_branch[i, 0]
        y_b = mamba2_branch(b_z, b_xbc, b_dt, conv_w[i], conv_b[i], ssm_a_log[i],
                            ssm_dt_bias[i], ssm_d[i], ssm_norm[i]) @ w_branch[i, 1]
        y_c = mla_branch(c_q, c_kv, c_kr, positions, mla_q_norm[i], mla_kv_norm[i],
                         mla_w_uq[i], mla_w_ukv[i]) @ w_branch[i, 2]
        gates = jax.nn.sigmoid(gate_pre.reshape(bsz, seq, N_BRANCH, D_MODEL))
        merged = gates[:, :, 0] * y_a + gates[:, :, 1] * y_b + gates[:, :, 2] * y_c
        h = h + merged @ w_out[i]
        h = h + HALF_STEP * swiglu(rmsnorm(h, ffn2_norm[i]), ffn2_w13[i], ffn2_w2[i])
        ple_gate = jax.nn.sigmoid(rmsnorm(h, ple_norm[i]) @ w_ple_gate[i])
        h = h + ple_gate * (p[i] @ w_ple_proj[i])
    return rmsnorm(h, final_norm)
```

```cpp
#include <hip/hip_runtime.h>
#include <cstdio>
#include <cstdint>
#include <cstring>

#define DEV __device__ __forceinline__
#define LAS __attribute__((address_space(3)))
#define GAS __attribute__((address_space(1)))
typedef unsigned short bf16;
typedef unsigned long long u64;
typedef short bf16x8 __attribute__((ext_vector_type(8)));
typedef short s16x4 __attribute__((ext_vector_type(4)));
typedef float f32x4 __attribute__((ext_vector_type(4)));
typedef float f32x16 __attribute__((ext_vector_type(16)));
typedef unsigned u32x4 __attribute__((ext_vector_type(4)));
typedef unsigned u32x2 __attribute__((ext_vector_type(2)));

namespace pg8 {
#define PG8_LAS __attribute__((address_space(3)))
typedef unsigned short bf16_t;
constexpr int BM = 256, BK = 64, HALF = 128, HTB = HALF * BK * 2, STAGE_BYTES = 8 * HTB, NXCD = 8, WGM = 4;

__host__ __device__ __forceinline__ int lds_byte(int r, int c) { const int st = (r >> 4) * 2 + (c >> 5), rr = r & 15, cc = c & 31, ob = rr * 64 + cc * 2; return st * 1024 + (ob ^ (((ob >> 9) & 1) << 5)); }
__host__ __device__ __forceinline__ void stage_rc(int b, int& R, int& C) { const int st = b / 1024, sb = b % 1024, swz = sb ^ (((sb >> 9) & 1) << 5); R = (st >> 1) * 16 + swz / 64; C = (st & 1) * 32 + (swz % 64) / 2; }
__host__ __device__ __forceinline__ int perm32(int rho) { const int n = rho >> 4, i = rho & 15; return 8 * (i >> 2) + 4 * n + (i & 3); }

struct Unit { int pm, pn; };
struct Gemm { const bf16_t* A; const bf16_t* Bt; int lda, ldb, K; };

struct StaticOrder {
    int nM, nN, nwg, G, c;
    __host__ __device__ void init(int M, int N, int G_, int c_) { nM = M / BM; nN = N / BM; nwg = nM * nN; G = G_; c = c_; }
    __host__ __device__ bool next(int i, Unit& u) const {
        const long L = (long)i * G + c; if (L >= nwg) return false;
        int wgid = (int)L; { const int q = nwg / NXCD, r = nwg % NXCD, xcd = wgid % NXCD, off = wgid / NXCD; wgid = (xcd < r ? xcd * (q + 1) : r * (q + 1) + (xcd - r) * q) + off; }
        const int nig = WGM * nN, gid = wgid / nig, fm = gid * WGM, gsz = (nM - fm) < WGM ? (nM - fm) : WGM;
        u.pm = fm + ((wgid % nig) % gsz); u.pn = (wgid % nig) / gsz; return true;
    }
};
struct BranchOrder {
    int G, c;
    __host__ __device__ bool next(int i, Unit& u) const {
        StaticOrder S; S.init(16384, 2048, G, c); Unit t; if (!S.next(i / 3, t)) return false;
        const int j = i % 3; u.pm = j * 64 + t.pm; u.pn = j * 8 + t.pn; return true;
    }
};

constexpr int PRE_OFF = STAGE_BYTES;
template <class Epi, class Sched, bool ALIGN_EPI>
__device__ __forceinline__ void gemm_phase(PG8_LAS unsigned char* lds, const Gemm g, const Sched& S, const Epi& E, int tid_in) {
    int tid_ = tid_in; asm volatile("" : "+v"(tid_));
    const int tid = tid_, wid = __builtin_amdgcn_readfirstlane(tid >> 6), lane = tid & 63, wr = wid >> 2, wc = wid & 3, fr = lane & 15, fq = lane >> 4;
    const int K = g.K, nt = K / BK;
    unsigned voffA[2], voffB[2];
#pragma unroll
    for (int i = 0; i < 2; ++i) { int R, C; stage_rc(tid * 16 + i * 8192, R, C); const int Rb = (R & ~31) + perm32(R & 31);
        voffA[i] = (unsigned)(R * g.lda + C) * 2u; voffB[i] = (unsigned)(Rb * g.ldb + C) * 2u; }
    const size_t kstep = (size_t)(BK * 2);
    const size_t hstepA = (size_t)HALF * g.lda * 2, hstepB = (size_t)HALF * g.ldb * 2;
    const size_t tstepA = 2 * hstepA, tstepB = 2 * hstepB;
    const unsigned ldsw = (unsigned)wid * 1024u;
    const int aoff = lds_byte(wr * 64 + fr, fq * 8), boff = lds_byte(wc * 32 + fr, fq * 8);
#define PG8_SA(b, h) (((b) * 2 + (h)) * HTB)
#define PG8_SB(b, h) ((4 + (b) * 2 + (h)) * HTB)
#define PG8_STAGE(bufoff, gbase, voff) do { _Pragma("unroll") for (int _i = 0; _i < 2; ++_i) \
        __builtin_amdgcn_global_load_lds((const unsigned*)((const char*)(gbase) + (voff)[_i]), (PG8_LAS unsigned*)(lds + (bufoff) + ldsw + _i * 8192), 16, 0, 0); } while (0)
#define PG8_LDA(dst, b, h) do { _Pragma("unroll") for (int m = 0; m < 4; ++m) _Pragma("unroll") for (int k = 0; k < 2; ++k) dst[m][k] = *(const PG8_LAS bf16x8*)(lds + PG8_SA(b, h) + aoff + m * 2048 + k * 1024); } while (0)
#define PG8_LDB(dst, b, h) do { _Pragma("unroll") for (int n = 0; n < 2; ++n) _Pragma("unroll") for (int k = 0; k < 2; ++k) dst[n][k] = *(const PG8_LAS bf16x8*)(lds + PG8_SB(b, h) + boff + n * 2048 + k * 1024); } while (0)
#define PG8_MMA(ai, bj, At, Bt) do { __builtin_amdgcn_s_setprio(1); _Pragma("unroll") for (int m = 0; m < 4; ++m) _Pragma("unroll") for (int n = 0; n < 2; ++n) _Pragma("unroll") for (int k = 0; k < 2; ++k) \
        acc[ai][bj][m][n] = __builtin_amdgcn_mfma_f32_16x16x32_bf16(Bt[n][k], At[m][k], acc[ai][bj][m][n], 0, 0, 0); __builtin_amdgcn_s_setprio(0); } while (0)
#define PG8_WAIT_V(n) asm volatile("s_waitcnt vmcnt(" #n ")" ::: "memory")
#define PG8_WAIT_L(n) asm volatile("s_waitcnt lgkmcnt(" #n ")" ::: "memory")
#define PG8_BAR __builtin_amdgcn_s_barrier()
#define PG8_SCHED __builtin_amdgcn_sched_barrier(0)
    Unit cur, nxt; int ui = 0;
    if (!S.next(0, cur)) return;
    PG8_LAS unsigned long long* const pre = (PG8_LAS unsigned long long*)(lds + PRE_OFF + wid * 1024);
#define PG8_PRE(u) do { if constexpr (Epi::PRE) { int ln_ = lane; asm volatile("" : "+v"(ln_));     \
        const int prerow = wr * 64 + ((ln_ >> 5) & 1) * 128 + ((ln_ >> 3) & 3) * 16 + 2 * (ln_ & 7); \
        __builtin_amdgcn_global_load_lds((const unsigned*)(E.pre_ptr() + (u).pm * 256 + prerow), (PG8_LAS unsigned*)pre, 16, 0, 0); } } while (0)
    PG8_PRE(cur);
    f32x4 acc[2][2][4][2];
#pragma unroll
    for (int a = 0; a < 2; ++a)
#pragma unroll
        for (int b = 0; b < 2; ++b)
#pragma unroll
            for (int m = 0; m < 4; ++m)
#pragma unroll
                for (int n = 0; n < 2; ++n) acc[a][b][m][n] = (f32x4){0.f, 0.f, 0.f, 0.f};
    bf16x8 At[4][2], B0[2][2], B1[2][2];
    const char* cA = (const char*)g.A + (size_t)cur.pm * tstepA; const char* cB = (const char*)g.Bt + (size_t)cur.pn * tstepB;
    PG8_STAGE(PG8_SB(0, 0), cB, voffB); PG8_STAGE(PG8_SB(0, 1), cB + hstepB, voffB); PG8_STAGE(PG8_SA(0, 0), cA, voffA); PG8_STAGE(PG8_SA(0, 1), cA + hstepA, voffA);
    if (wr == 1) PG8_BAR;
    PG8_WAIT_V(2); PG8_BAR;
    PG8_STAGE(PG8_SB(1, 0), cB + kstep, voffB); PG8_STAGE(PG8_SA(1, 0), cA + kstep, voffA); PG8_STAGE(PG8_SB(1, 1), cB + hstepB + kstep, voffB);
    PG8_WAIT_V(6); PG8_BAR;
    for (;;) {
        const bool has_next = S.next(ui + 1, nxt);
        const char* nA = has_next ? (const char*)g.A + (size_t)nxt.pm * tstepA : cA; const char* nB = has_next ? (const char*)g.Bt + (size_t)nxt.pn * tstepB : cB;
#pragma unroll 1
        for (int t = 0; t < nt; t += 2) {
            const bool last = (t == nt - 2);
            const char* a1 = cA + (size_t)(t + 1) * kstep;
            const char* a2 = last ? nA : cA + (size_t)(t + 2) * kstep; const char* b2 = last ? nB : cB + (size_t)(t + 2) * kstep;
            const char* a3 = a2 + kstep; const char* b3 = b2 + kstep;
            PG8_LDB(B0, 0, 0); PG8_LDB(B1, 0, 1); PG8_SCHED; PG8_LDA(At, 0, 0); PG8_STAGE(PG8_SA(1, 1), a1 + hstepA, voffA);
            PG8_WAIT_V(8); PG8_WAIT_L(0); PG8_BAR; PG8_MMA(0, 0, At, B0); PG8_MMA(0, 1, At, B1); PG8_BAR; PG8_SCHED;
            PG8_LDA(At, 0, 1); PG8_STAGE(PG8_SB(0, 0), b2, voffB); PG8_STAGE(PG8_SB(0, 1), b2 + hstepB, voffB); PG8_STAGE(PG8_SA(0, 0), a2, voffA);
            PG8_WAIT_V(8); PG8_WAIT_L(0); PG8_BAR; PG8_MMA(1, 0, At, B0); PG8_MMA(1, 1, At, B1); PG8_BAR; PG8_SCHED;
            PG8_LDB(B0, 1, 0); PG8_LDB(B1, 1, 1); PG8_SCHED; PG8_LDA(At, 1, 0); PG8_STAGE(PG8_SA(0, 1), a2 + hstepA, voffA);
            PG8_WAIT_V(8); PG8_WAIT_L(0); PG8_BAR; PG8_MMA(0, 0, At, B0); PG8_MMA(0, 1, At, B1); PG8_BAR; PG8_SCHED;
            PG8_LDA(At, 1, 1); PG8_STAGE(PG8_SB(1, 0), b3, voffB); PG8_STAGE(PG8_SB(1, 1), b3 + hstepB, voffB); PG8_STAGE(PG8_SA(1, 0), a3, voffA);
            PG8_WAIT_V(8); PG8_WAIT_L(0); PG8_BAR; PG8_MMA(1, 0, At, B0); PG8_MMA(1, 1, At, B1); PG8_BAR; PG8_SCHED;
        }
        if constexpr (ALIGN_EPI) { if (wr == 0) PG8_BAR; }
        E(acc, cur, wr, wc, fr, fq, pre);
        if (!has_next) break;
        if constexpr (Epi::PRE) { PG8_WAIT_L(0); PG8_PRE(nxt); }
#pragma unroll
        for (int a = 0; a < 2; ++a)
#pragma unroll
            for (int b = 0; b < 2; ++b)
#pragma unroll
                for (int m = 0; m < 4; ++m)
#pragma unroll
                    for (int n = 0; n < 2; ++n) acc[a][b][m][n] = (f32x4){0.f, 0.f, 0.f, 0.f};
        cur = nxt; cA = nA; cB = nB; ++ui;
        if constexpr (ALIGN_EPI) { if (wr == 1) PG8_BAR; }
    }
    PG8_WAIT_V(0);
    if constexpr (!ALIGN_EPI) { if (wr == 0) PG8_BAR; }
    PG8_BAR;
#undef PG8_PRE
#undef PG8_SA
#undef PG8_SB
#undef PG8_STAGE
#undef PG8_LDA
#undef PG8_LDB
#undef PG8_MMA
#undef PG8_WAIT_V
#undef PG8_WAIT_L
#undef PG8_BAR
#undef PG8_SCHED
}
}

#define XB_TMO      128
#define XB_XCNT(j)  (256  + 64 * (j))
#define XB_XSUB(j)  (1280 + 64 * (j))
#define XB_XGEN(j)  (2304 + 64 * (j))
#define XB_TOP      3328
#define XB_TOPGEN   3392
#define XCD_BAR_WORDS 3456
#define XB_SPIN_CAP (1u << 18)

__device__ __forceinline__ unsigned xb_ld(unsigned* p)              { return __hip_atomic_load(p, __ATOMIC_RELAXED, __HIP_MEMORY_SCOPE_AGENT); }
__device__ __forceinline__ unsigned xb_add(unsigned* p, unsigned v) { return __hip_atomic_fetch_add(p, v, __ATOMIC_RELAXED, __HIP_MEMORY_SCOPE_AGENT); }
__device__ __forceinline__ unsigned xb_xcc_id() { return (unsigned)__builtin_amdgcn_s_getreg((3 << 11) | 20) & 0xFu; }
#define XB_SPIN(cond, bar) do { unsigned _sp = 0; while (cond) { __builtin_amdgcn_s_sleep(1); \
    if ((++_sp & 255u) == 0u) { if (xb_ld(&(bar)[XB_TMO])) break; if (_sp > XB_SPIN_CAP) { atomicAdd(&(bar)[XB_TMO], 1u); break; } } } } while (0)

struct XcdBarrier { unsigned* bar; unsigned x; volatile LAS unsigned* st; };

__device__ __forceinline__ XcdBarrier xcd_barrier_post(unsigned* bar, volatile LAS unsigned* st) {
    XcdBarrier b; b.bar = bar; b.x = xb_xcc_id(); b.st = st;
    if (threadIdx.x == 0) (void)xb_add(&bar[XB_XCNT(b.x)], 1u);
    return b;
}
__device__ __forceinline__ void xcd_barrier_complete(unsigned* bar, unsigned x, unsigned& nloc, unsigned& nx) {
    const unsigned G = gridDim.x * gridDim.y * gridDim.z;
    unsigned sum, cnt, mine, sp = 0u;
    for (;;) {
        sum = 0u; cnt = 0u; mine = 0u;
#pragma unroll
        for (unsigned j = 0; j < 16; ++j) { const unsigned c = xb_ld(&bar[XB_XCNT(j)]); sum += c; cnt += (c > 0u) ? 1u : 0u; mine = (j == x) ? c : mine; }
        if (sum == G) break;
        __builtin_amdgcn_s_sleep(1);
        if ((++sp & 255u) == 0u) { if (xb_ld(&bar[XB_TMO])) break; if (sp > XB_SPIN_CAP) { atomicAdd(&bar[XB_TMO], 1u); break; } }
    }
    nloc = mine > 0u ? mine : 1u; nx = cnt > 0u ? cnt : 1u;
}
__device__ __forceinline__ void xcd_barrier(const XcdBarrier& b) {
    asm volatile("s_waitcnt vmcnt(0)" ::: "memory");
    __syncthreads();
    if (threadIdx.x == 0) {
        unsigned* bar = b.bar;
        __builtin_amdgcn_s_waitcnt(0);
        unsigned nloc = b.st[0], nx = b.st[1];
        if (nloc == 0u) { xcd_barrier_complete(bar, b.x, nloc, nx); b.st[0] = nloc; b.st[1] = nx; }
        const unsigned old = xb_add(&bar[XB_XSUB(b.x)], 1u);
        const unsigned gen = old / nloc;
        if (old + 1u == (gen + 1u) * nloc) {
            __builtin_amdgcn_fence(__ATOMIC_RELEASE, "agent");
            asm volatile("s_waitcnt vmcnt(0)" ::: "memory");
            const unsigned og = xb_add(&bar[XB_TOP], 1u);
            const unsigned tg = og / nx;
            if (og + 1u == (tg + 1u) * nx) xb_add(&bar[XB_TOPGEN], 1u);
            else XB_SPIN(xb_ld(&bar[XB_TOPGEN]) == tg, bar);
            __builtin_amdgcn_fence(__ATOMIC_ACQUIRE, "agent");
            xb_add(&bar[XB_XGEN(b.x)], 1u);
            asm volatile("s_waitcnt vmcnt(0)" ::: "memory");
        } else {
            XB_SPIN(xb_ld(&bar[XB_XGEN(b.x)]) == gen, bar);
            __builtin_amdgcn_fence(__ATOMIC_ACQUIRE, "agent");
            asm volatile("s_waitcnt vmcnt(0)" ::: "memory");
        }
    }
    __syncthreads();
}
constexpr int NB = 2, SEQ = 8192, M = NB * SEQ, DM = 2048, FF = 5632, DEPTH = 4, PLE = 256;
constexpr int DIN_SRC = 12912, ZW = 12800, WIN_ROWS = 13056;
constexpr int ZC_AQ = 0, ZC_AK = 512, ZC_AV = 1024, ZC_AO = 2048, ZC_BZ = 3072, ZC_XBC = 4096, ZC_CQ = 5632, ZC_CKV = 6144, ZC_GATE = 6656;
constexpr int SMW = 128;
constexpr float EPS = 1e-6f;
constexpr size_t MiB = 1u << 20;
constexpr size_t WS_CTL = 0, CTL_ZERO_BYTES = 8 * MiB;
constexpr int CW_BAR = 4096;
constexpr size_t OFF_HSS = 1 * MiB;
constexpr size_t OFF_CQSS = OFF_HSS + (size_t)17 * M * 8;
constexpr size_t OFF_CKVSS = OFF_CQSS + (size_t)4 * M * 8;
constexpr size_t OFF_YBSS = OFF_CKVSS + (size_t)4 * M * 8;
static_assert(OFF_YBSS + (size_t)4 * M * 8 <= CTL_ZERO_BYTES, "ctl");
constexpr size_t WS_W = 8 * MiB;
constexpr size_t WE_13A = 0, WE_2A = WE_13A + (size_t)2 * FF * DM, WE_IN = WE_2A + (size_t)DM * FF, WE_UQ = WE_IN + (size_t)WIN_ROWS * DM,
                 WE_UKV = WE_UQ + (size_t)1536 * 512, WE_BR = WE_UKV + (size_t)2048 * 512, WE_OUT = WE_BR + (size_t)3 * DM * 1024,
                 WE_13B = WE_OUT + (size_t)DM * DM, WE_2B = WE_13B + (size_t)2 * FF * DM, WE_PG = WE_2B + (size_t)DM * FF, WE_PP = WE_PG + (size_t)DM * DM,
                 WE_END = WE_PP + (size_t)DM * PLE;
static_assert(WE_END * 2 <= 216 * MiB, "weights");
constexpr size_t WS_H = 224 * MiB;
constexpr size_t WS_HB0 = 352 * MiB, WS_HB1 = 416 * MiB;
constexpr size_t WS_ZIN = 480 * MiB;
constexpr size_t WS_U = WS_ZIN;
constexpr size_t WS_SMALL = 880 * MiB;
constexpr size_t WS_Q = 888 * MiB;
constexpr size_t WS_KN = 936 * MiB;
constexpr size_t WS_V = 968 * MiB;
constexpr size_t WS_PP = WS_Q;
constexpr size_t WS_KR = 1000 * MiB;
constexpr size_t WS_COS = 1002 * MiB, WS_SIN = 1004 * MiB;
constexpr size_t WS_PB = 1006 * MiB;
constexpr size_t WS_MISC = 1014 * MiB;
constexpr size_t OFF_MLOC = 0, OFF_MG = 4096, OFF_M0 = 8192, OFF_NLOC = 16384  , OFF_SDEC = OFF_NLOC + 1024 * 128 * 4  ;
constexpr size_t WS_CLOC = 1016 * MiB;
constexpr size_t WS_MERGE = WS_CLOC;
constexpr size_t WS_SST = 1144 * MiB;
constexpr size_t WS_MERGEB = WS_SST;
constexpr size_t WS_Y = 1272 * MiB;
constexpr size_t WS_END = 1368 * MiB;

constexpr int LDS_BYTES = 155648;
constexpr int LDS_MISC = 153600;
constexpr int NWAVES = 8;

typedef float f32x2_t __attribute__((ext_vector_type(2))); typedef __bf16 bf16x2_t __attribute__((ext_vector_type(2)));
DEV unsigned f2bf(float f) { return (unsigned)__builtin_bit_cast(unsigned short, (__bf16)f); }
DEV unsigned pk2(float lo, float hi) { f32x2_t v = {lo, hi}; bf16x2_t b = __builtin_convertvector(v, bf16x2_t); return __builtin_bit_cast(unsigned, b); }
DEV float bf2f(unsigned short b) { return __builtin_bit_cast(float, (unsigned)b << 16); }
DEV float bflo(unsigned w) { return __builtin_bit_cast(float, w << 16); }
DEV float bfhi(unsigned w) { return __builtin_bit_cast(float, w & 0xffff0000u); }
DEV float sigmoidf_(float x) { return __builtin_amdgcn_rcpf(1.f + __expf(-x)); }
DEV float siluf_(float x) { return x * __builtin_amdgcn_rcpf(1.f + __expf(-x)); }
DEV float softplusf_(float x) { return fmaxf(x, 0.f) + log1pf(__expf(-fabsf(x))); }
DEV float logsigf_(float x) { return fminf(x, 0.f) - log1pf(__expf(-fabsf(x))); }
DEV float ss_to_rstd(u64 s, float inv_n) { return rsqrtf((float)s * (1.f / 4294967296.f) * inv_n + EPS); }
DEV void ss_add(u64* p, float part) { atomicAdd((unsigned long long*)p, (unsigned long long)(part * 4294967296.f)); }
DEV float shx(float v, int m, int lane) { return __uint_as_float((unsigned)__builtin_amdgcn_ds_bpermute((lane ^ m) << 2, (int)__float_as_uint(v))); }
DEV float shup(float v, int d, int lane) { const int src = lane >= d ? lane - d : lane; return __uint_as_float((unsigned)__builtin_amdgcn_ds_bpermute(src << 2, (int)__float_as_uint(v))); }
DEV float xsum16(float v) { auto r = __builtin_amdgcn_permlane16_swap(__float_as_uint(v), __float_as_uint(v), false, false); return __uint_as_float(r[0]) + __uint_as_float(r[1]); }
DEV float xsum32(float v) { auto r = __builtin_amdgcn_permlane32_swap(__float_as_uint(v), __float_as_uint(v), false, false); return __uint_as_float(r[0]) + __uint_as_float(r[1]); }
DEV float wave_sum(float v, int lane) {
#pragma unroll
    for (int o = 1; o < 16; o <<= 1) v += shx(v, o, lane);
    return xsum32(xsum16(v));
}
DEV float wave_max(float v, int lane) {
#pragma unroll
    for (int o = 1; o < 64; o <<= 1) v = fmaxf(v, shx(v, o, lane));
    return v;
}
DEV u32x4 pack8(const float* v) { u32x4 w; w.x = pk2(v[0], v[1]); w.y = pk2(v[2], v[3]); w.z = pk2(v[4], v[5]); w.w = pk2(v[6], v[7]); return w; }
DEV void unpack8(u32x4 w, float* v) { v[0] = bflo(w.x); v[1] = bfhi(w.x); v[2] = bflo(w.y); v[3] = bfhi(w.y); v[4] = bflo(w.z); v[5] = bfhi(w.z); v[6] = bflo(w.w); v[7] = bfhi(w.w); }

typedef f32x4 Acc[2][2][4][2];
#define EPI_ROWS(...) _Pragma("unroll") for (int ai = 0; ai < 2; ++ai) _Pragma("unroll") for (int m = 0; m < 4; ++m) { const int rg = ai * 4 + m; const int row = row0 + ai * 128 + m * 16; __VA_ARGS__ }
DEV void load_rstd8(float (&rs)[8], const u64* ss, int row0, float inv_n) {
    u64 t[8];
#pragma unroll
    for (int rg = 0; rg < 8; ++rg) t[rg] = *(const GAS u64*)(ss + row0 + (rg >> 2) * 128 + (rg & 3) * 16);
#pragma unroll
    for (int rg = 0; rg < 8; ++rg) rs[rg] = ss_to_rstd(t[rg], inv_n);
}
typedef const LAS u64* PrePtr;
DEV void lds_rstd8(float (&rs)[8], PrePtr pre, int fr, float inv_n) {
    u64 t[8];
#pragma unroll
    for (int rg = 0; rg < 8; ++rg) t[rg] = pre[rg * 16 + fr];
#pragma unroll
    for (int rg = 0; rg < 8; ++rg) rs[rg] = ss_to_rstd(t[rg], inv_n);
}
struct EpiSwiGLU {
    static constexpr bool PRE = true; const u64* ss; bf16* U; DEV const u64* pre_ptr() const { return ss; }
    DEV void operator()(const Acc& acc, const pg8::Unit& u, int wr, int wc, int fr, int fq, PrePtr pre) const {
        const int row0 = u.pm * 256 + wr * 64 + fr, col0 = u.pn * 128 + wc * 32 + 8 * fq;
        float rs[8]; lds_rstd8(rs, pre, fr, 1.f / DM);
        EPI_ROWS( float o[8];
            _Pragma("unroll") for (int n = 0; n < 2; ++n) _Pragma("unroll") for (int i = 0; i < 4; ++i) { const float a = acc[ai][0][m][n][i] * rs[rg], b = acc[ai][1][m][n][i] * rs[rg]; o[n * 4 + i] = siluf_(a) * b; }
            *(GAS u32x4*)(U + (size_t)row * FF + col0) = pack8(o); )
    }
};
template <int MODE> struct EpiResid {
    static constexpr bool PRE = false; const bf16* HBi; bf16* HBo; u64* sso; float alpha; const u64* ssi; const bf16* PP;
    DEV void operator()(const Acc& acc, const pg8::Unit& u, int wr, int wc, int fr, int fq, PrePtr pre) const {
        const int row0 = u.pm * 256 + wr * 64 + fr, col0 = u.pn * 256 + wc * 32 + 8 * fq;
        float rs[8]; if (MODE == 1) load_rstd8(rs, ssi, row0, 1.f / DM);
        constexpr int MB = (MODE == 1) ? 2 : 4;
#pragma unroll
        for (int bt = 0; bt < 8 / MB; ++bt) {
            u32x4 hb[MB][2], pq[MB][2];
#pragma unroll
            for (int mm = 0; mm < MB; ++mm)
#pragma unroll
                for (int bj = 0; bj < 2; ++bj) { const int rg = bt * MB + mm; const size_t off = (size_t)(row0 + (rg >> 2) * 128 + (rg & 3) * 16) * DM + col0 + bj * 128;
                    hb[mm][bj] = *(const GAS u32x4*)(HBi + off); if (MODE == 1) pq[mm][bj] = *(const GAS u32x4*)(PP + off); }
            __builtin_amdgcn_sched_barrier(0);
#pragma unroll
            for (int mm = 0; mm < MB; ++mm) { const int rg = bt * MB + mm, ai = rg >> 2, m = rg & 3; const int row = row0 + ai * 128 + m * 16; float part = 0.f;
#pragma unroll
                for (int bj = 0; bj < 2; ++bj) { float hv[8], pv[8], o[8]; unpack8(hb[mm][bj], hv); if (MODE == 1) unpack8(pq[mm][bj], pv);
#pragma unroll
                    for (int n = 0; n < 2; ++n)
#pragma unroll
                        for (int i = 0; i < 4; ++i) { const int e = n * 4 + i;
                            o[e] = (MODE == 0) ? hv[e] + alpha * acc[ai][bj][m][n][i] : hv[e] + sigmoidf_(acc[ai][bj][m][n][i] * rs[rg]) * pv[e]; part += o[e] * o[e]; }
                    *(GAS u32x4*)(HBo + (size_t)row * DM + col0 + bj * 128) = pack8(o); }
                part = xsum32(xsum16(part));
                if (fq == 0) ss_add(sso + row, part); }
        }
    }
};
struct EpiWin {
    static constexpr bool PRE = true; DEV const u64* pre_ptr() const { return ssi; } const u64* ssi; bf16* ZIN; float* SMALL; u64* cqss; u64* ckvss;
    template <bool GATE> DEV void body(const Acc& acc, const pg8::Unit& u, int row0, int cw, int fq, const float (&rs)[8]) const {
        const int pn = u.pn; const bool stat = (pn >= 22 && pn < 26);
        EPI_ROWS( float part = 0.f;
            _Pragma("unroll") for (int bj = 0; bj < 2; ++bj) { float o[8];
                _Pragma("unroll") for (int n = 0; n < 2; ++n) _Pragma("unroll") for (int i = 0; i < 4; ++i) { float v = acc[ai][bj][m][n][i] * rs[rg]; if (!GATE) part += v * v; o[n * 4 + i] = GATE ? sigmoidf_(v) : v; }
                if (GATE || pn < 50) *(GAS u32x4*)(ZIN + (size_t)row * ZW + pn * 256 + bj * 128 + cw) = pack8(o);
                else if (bj == 0) { GAS float* d = (GAS float*)(SMALL + (size_t)row * SMW + cw); *(GAS f32x4*)d = (f32x4){o[0], o[1], o[2], o[3]}; *(GAS f32x4*)(d + 4) = (f32x4){o[4], o[5], o[6], o[7]}; } }
            if (!GATE && stat) { part = xsum32(xsum16(part)); if (fq == 0) ss_add((pn < 24 ? cqss : ckvss) + row, part); } )
    }
    DEV void operator()(const Acc& acc, const pg8::Unit& u, int wr, int wc, int fr, int fq, PrePtr pre) const {
        const int row0 = u.pm * 256 + wr * 64 + fr, cw = wc * 32 + 8 * fq;
        float rs[8]; lds_rstd8(rs, pre, fr, 1.f / DM);
        if (u.pn >= 26 && u.pn < 50) body<true>(acc, u, row0, cw, fq, rs);
        else body<false>(acc, u, row0, cw, fq, rs);
    }
};
struct EpiQup {
    static constexpr bool PRE = true; DEV const u64* pre_ptr() const { return ss; } const u64* ss; bf16* Q; const float* COS; const float* SIN;
    DEV void operator()(const Acc& acc, const pg8::Unit& u, int wr, int wc, int fr, int fq, PrePtr pre) const {
        const int row0 = u.pm * 256 + wr * 64 + fr, pn = u.pn;
        float rs[8]; lds_rstd8(rs, pre, fr, 1.f / 512.f);
        EPI_ROWS( const int b = row >> 13, s = row & (SEQ - 1);
            if (pn < 4) {
                _Pragma("unroll") for (int bj = 0; bj < 2; ++bj) { const int head = 2 * pn + bj; float o[8];
                    _Pragma("unroll") for (int n = 0; n < 2; ++n) _Pragma("unroll") for (int i = 0; i < 4; ++i) o[n * 4 + i] = acc[ai][bj][m][n][i] * rs[rg];
                    *(GAS u32x4*)(Q + ((size_t)(b * 8 + head) * SEQ + s) * 192 + wc * 32 + 8 * fq) = pack8(o); }
            } else { const int head = 4 * (pn - 4) + wc, j0 = 8 * fq; float o1[8], o2[8];
                const f32x4 c0 = *(const GAS f32x4*)(COS + (size_t)row * 32 + j0), c1 = *(const GAS f32x4*)(COS + (size_t)row * 32 + j0 + 4);
                const f32x4 s0 = *(const GAS f32x4*)(SIN + (size_t)row * 32 + j0), s1 = *(const GAS f32x4*)(SIN + (size_t)row * 32 + j0 + 4);
                _Pragma("unroll") for (int n = 0; n < 2; ++n) _Pragma("unroll") for (int i = 0; i < 4; ++i) { const float x1 = acc[ai][0][m][n][i] * rs[rg], x2 = acc[ai][1][m][n][i] * rs[rg]; const float cs = n ? c1[i] : c0[i], sn = n ? s1[i] : s0[i];
                    o1[n * 4 + i] = x1 * cs - x2 * sn; o2[n * 4 + i] = x2 * cs + x1 * sn; }
                bf16* qp = Q + ((size_t)(b * 8 + head) * SEQ + s) * 192 + 128 + j0;
                *(GAS u32x4*)qp = pack8(o1); *(GAS u32x4*)(qp + 32) = pack8(o2); } )
    }
};
struct EpiKVup {
    static constexpr bool PRE = true; DEV const u64* pre_ptr() const { return ss; } const u64* ss; bf16* KN; bf16* V;
    DEV void operator()(const Acc& acc, const pg8::Unit& u, int wr, int wc, int fr, int fq, PrePtr pre) const {
        const int row0 = u.pm * 256 + wr * 64 + fr, head = u.pn;
        float rs[8]; lds_rstd8(rs, pre, fr, 1.f / 512.f);
        EPI_ROWS( const int b = row >> 13, s = row & (SEQ - 1); const size_t off = ((size_t)(b * 8 + head) * SEQ + s) * 128 + wc * 32 + 8 * fq;
            _Pragma("unroll") for (int bj = 0; bj < 2; ++bj) { float o[8];
                _Pragma("unroll") for (int n = 0; n < 2; ++n) _Pragma("unroll") for (int i = 0; i < 4; ++i) o[n * 4 + i] = acc[ai][bj][m][n][i] * rs[rg];
                *(GAS u32x4*)((bj ? V : KN) + off) = pack8(o); } )
    }
};
struct EpiPlain {
    static constexpr bool PRE = false; bf16* O; int ldc;
    DEV void operator()(const Acc& acc, const pg8::Unit& u, int wr, int wc, int fr, int fq, PrePtr pre) const {
        const int row0 = u.pm * 256 + wr * 64 + fr, col0 = u.pn * 256 + wc * 32 + 8 * fq;
        EPI_ROWS( (void)rg;
            _Pragma("unroll") for (int bj = 0; bj < 2; ++bj) { float o[8];
                _Pragma("unroll") for (int n = 0; n < 2; ++n) _Pragma("unroll") for (int i = 0; i < 4; ++i) o[n * 4 + i] = acc[ai][bj][m][n][i];
                *(GAS u32x4*)(O + (size_t)row * ldc + col0 + bj * 128) = pack8(o); } )
    }
};
#ifndef DBG_DBL
#define DBG_DBL 0
#endif
#ifndef DBG_ZERO
#define DBG_ZERO 0
#endif
struct EpiBranch {
    static constexpr bool PRE = false; const bf16* ZIN; const u64* ybss; bf16* MERGEB;
    DEV void operator()(const Acc& acc, const pg8::Unit& u, int wr, int wc, int fr, int fq, PrePtr pre) const {
        const int j = u.pm >> 6, pm = u.pm & 63, pn = u.pn & 7;
        const int row0 = pm * 256 + wr * 64 + fr, col0 = pn * 256 + wc * 32 + 8 * fq;
        float rs[8];
        if (j == 1) load_rstd8(rs, ybss, row0, 1.f / 1024.f);
        else {
#pragma unroll
            for (int rg = 0; rg < 8; ++rg) rs[rg] = 1.f; }
        u32x4 gq[2][2], mq[2][2];
#define BR_LOAD(slot, rgx) _Pragma("unroll") for (int bj = 0; bj < 2; ++bj) { const int row = row0 + ((rgx) >> 2) * 128 + ((rgx) & 3) * 16, col = col0 + bj * 128; \
            gq[slot][bj] = *(const GAS u32x4*)(ZIN + (size_t)row * ZW + ZC_GATE + j * DM + col); \
            mq[slot][bj] = (u32x4){0u, 0u, 0u, 0u}; if (j > 0) mq[slot][bj] = *(const GAS u32x4*)(MERGEB + (size_t)row * DM + col); }
        BR_LOAD(0, 0)
#pragma unroll
        for (int rg = 0; rg < 8; ++rg) {
            if (rg + 1 < 8) { if ((rg & 1) == 0) { BR_LOAD(1, rg + 1) } else { BR_LOAD(0, rg + 1) } }
            __builtin_amdgcn_sched_barrier(0);
#pragma unroll
            for (int bj = 0; bj < 2; ++bj) { const int ai = rg >> 2, m = rg & 3; const int row = row0 + ai * 128 + m * 16, col = col0 + bj * 128; float g[8], p[8], o[8]; unpack8(gq[rg & 1][bj], g); unpack8(mq[rg & 1][bj], p);
#pragma unroll
                for (int n = 0; n < 2; ++n)
#pragma unroll
                    for (int i = 0; i < 4; ++i) o[n * 4 + i] = p[n * 4 + i] + (((DBG_ZERO >> j) & 1) ? 0.f : acc[ai][bj][m][n][i] * rs[rg] * g[n * 4 + i] * (((DBG_DBL >> j) & 1) ? 2.f : 1.f));
                *(GAS u32x4*)(MERGEB + (size_t)row * DM + col) = pack8(o); }
        }
#undef BR_LOAD
    }
};
#undef EPI_ROWS
struct Params {
    const float* in[30];
    float* out; unsigned char* ws;
    int l_lo, l_hi, ph_lo, ph_hi;
    int use_bar, pad;
};
enum { I_X = 0, I_P, I_POS, I_F1N, I_F1W13, I_F1W2, I_MIXN, I_WIN, I_BIG, I_BFG, I_MLN, I_CONVW, I_CONVB, I_ALOG, I_DTB, I_SSD, I_SSN,
       I_QN, I_KVN, I_WUQ, I_WUKV, I_WBR, I_WOUT, I_F2N, I_F2W13, I_F2W2, I_PLN, I_WPG, I_WPP, I_FIN };

struct Ctx {
    LAS unsigned char* lds; unsigned char* ws; int tid, lane, wave, G, bid;
};
DEV Ctx fresh(const Ctx& C0) { Ctx C = C0;
    int wv = C0.wave; unsigned char* w = C0.ws; int g = C0.G, b = C0.bid; asm volatile("" : "+s"(wv), "+s"(w), "+s"(g), "+s"(b));
    int ln = (int)__builtin_amdgcn_mbcnt_hi(~0u, __builtin_amdgcn_mbcnt_lo(~0u, 0u)); asm volatile("" : "+v"(ln));
    C.wave = wv; C.lane = ln; C.tid = wv * 64 + ln; C.ws = w; C.G = g; C.bid = b; return C; }

__constant__ double INVF[32] = {1.0, 0.7498942093324559, 0.5623413251903491, 0.4216965034285822, 0.31622776601683794, 0.23713737056616552, 0.1778279410038923, 0.1333521432163324, 0.1, 0.07498942093324558, 0.05623413251903491, 0.042169650342858224, 0.03162277660168379, 0.023713737056616554, 0.01778279410038923, 0.01333521432163324, 0.01, 0.007498942093324558, 0.005623413251903491, 0.004216965034285823, 0.0031622776601683794, 0.0023713737056616554, 0.0017782794100389228, 0.001333521432163324, 0.001, 0.0007498942093324559, 0.0005623413251903491, 0.00042169650342858224, 0.00031622776601683794, 0.00023713737056616554, 0.00017782794100389227, 0.0001333521432163324};
struct MapId  { DEV int operator()(int r) const { return r; } };
struct MapW13 { DEV int operator()(int r) const { const int t = r >> 8, w = r & 255; return (w >= 128 ? FF : 0) + 128 * t + (w & 127); } };
struct MapWin { DEV int operator()(int r) const {
    if (r < 3072) return r; if (r < 5632) return r + 16; if (r < 6656) return r + 48; if (r < 12800) return r + 112;
    r -= 12800; if (r < 16) return 3072 + r; if (r < 48) return 5648 + (r - 16); if (r < 112) return 6704 + (r - 48); return -1; } };
struct MapUq  { DEV int operator()(int r) const {
    if (r < 1024) return (r >> 7) * 192 + (r & 127);
    const int rr = r - 1024, tile = rr >> 8, w = rr & 255, t2 = w >> 7, hl = (w & 127) >> 5, j = w & 31; return (4 * tile + hl) * 192 + 128 + 32 * t2 + j; } };

struct CvtItem { const float* W; const float* gain; bf16* WT; int ldw, K, sc, kk0, row; };
DEV int cvt_map(int id, int r) { return id == 0 ? MapId()(r) : id == 1 ? MapW13()(r) : id == 2 ? MapWin()(r) : MapUq()(r); }
DEV CvtItem cvt_describe(const Params& P, unsigned char* ws, int L, int it, int lane) {
    constexpr int N13 = (2 * FF / 64) * (DM / 64), N2 = (DM / 64) * (FF / 64), NIN = (WIN_ROWS / 64) * (DM / 64), NUQ = (1536 / 64) * (512 / 64), NUKV = (2048 / 64) * (512 / 64),
                  NBR = (DM / 64) * (1024 / 64), NSQ = (DM / 64) * (DM / 64);
    bf16* WB = (bf16*)(ws + WS_W); CvtItem d; int r = it, mapid = 0;
    if (r < N13) { d.W = P.in[I_F1W13] + (size_t)L * DM * 2 * FF; d.ldw = 2 * FF; d.K = DM; d.gain = P.in[I_F1N] + L * DM; d.WT = WB + WE_13A; mapid = 1; }
    else if ((r -= N13) < N13) { d.W = P.in[I_F2W13] + (size_t)L * DM * 2 * FF; d.ldw = 2 * FF; d.K = DM; d.gain = P.in[I_F2N] + L * DM; d.WT = WB + WE_13B; mapid = 1; }
    else if ((r -= N13) < N2) { d.W = P.in[I_F1W2] + (size_t)L * FF * DM; d.ldw = DM; d.K = FF; d.gain = nullptr; d.WT = WB + WE_2A; }
    else if ((r -= N2) < N2) { d.W = P.in[I_F2W2] + (size_t)L * FF * DM; d.ldw = DM; d.K = FF; d.gain = nullptr; d.WT = WB + WE_2B; }
    else if ((r -= N2) < NIN) { d.W = P.in[I_WIN] + (size_t)L * DM * DIN_SRC; d.ldw = DIN_SRC; d.K = DM; d.gain = P.in[I_MIXN] + L * DM; d.WT = WB + WE_IN; mapid = 2; }
    else if ((r -= NIN) < NUQ) { d.W = P.in[I_WUQ] + (size_t)L * 512 * 1536; d.ldw = 1536; d.K = 512; d.gain = P.in[I_QN] + L * 512; d.WT = WB + WE_UQ; mapid = 3; }
    else if ((r -= NUQ) < NUKV) { d.W = P.in[I_WUKV] + (size_t)L * 512 * 2048; d.ldw = 2048; d.K = 512; d.gain = P.in[I_KVN] + L * 512; d.WT = WB + WE_UKV; }
    else if ((r -= NUKV) < 3 * NBR) { const int j = r / NBR; r -= j * NBR; d.W = P.in[I_WBR] + (size_t)L * 3 * 1024 * DM + (size_t)j * 1024 * DM; d.ldw = DM; d.K = 1024; d.gain = (j == 1) ? P.in[I_SSN] + L * 1024 : nullptr; d.WT = WB + WE_BR + (size_t)j * DM * 1024; }
    else if ((r -= 3 * NBR) < NSQ) { d.W = P.in[I_WOUT] + (size_t)L * DM * DM; d.ldw = DM; d.K = DM; d.gain = nullptr; d.WT = WB + WE_OUT; }
    else if ((r -= NSQ) < NSQ) { d.W = P.in[I_WPG] + (size_t)L * DM * DM; d.ldw = DM; d.K = DM; d.gain = P.in[I_PLN] + L * DM; d.WT = WB + WE_PG; }
    else { r -= NSQ; d.W = P.in[I_WPP] + (size_t)L * PLE * DM; d.ldw = DM; d.K = PLE; d.gain = nullptr; d.WT = WB + WE_PP; }
    const int nkb = d.K / 64, rb = r / nkb, kb = r - rb * nkb; d.row = 64 * rb + (lane & 15) * 4; d.kk0 = 64 * kb + 16 * (lane >> 4); d.sc = cvt_map(mapid, d.row);
    return d;
}
DEV void cvt_load(const CvtItem& d, f32x4 (&v)[16]) {
#pragma unroll
    for (int i = 0; i < 16; ++i) { v[i] = (f32x4){0.f, 0.f, 0.f, 0.f}; if (d.sc >= 0) v[i] = *(const GAS f32x4*)(d.W + (size_t)(d.kk0 + i) * d.ldw + d.sc); }
}
DEV void cvt_store(const CvtItem& d, const f32x4 (&v)[16]) {
    f32x4 g[4];
#pragma unroll
    for (int q = 0; q < 4; ++q) g[q] = d.gain ? *(const GAS f32x4*)(d.gain + d.kk0 + 4 * q) : (f32x4){1.f, 1.f, 1.f, 1.f};
#pragma unroll
    for (int jn = 0; jn < 4; ++jn) { u32x4 o0, o1;
        o0.x = pk2(v[0][jn] * g[0][0], v[1][jn] * g[0][1]); o0.y = pk2(v[2][jn] * g[0][2], v[3][jn] * g[0][3]); o0.z = pk2(v[4][jn] * g[1][0], v[5][jn] * g[1][1]); o0.w = pk2(v[6][jn] * g[1][2], v[7][jn] * g[1][3]);
        o1.x = pk2(v[8][jn] * g[2][0], v[9][jn] * g[2][1]); o1.y = pk2(v[10][jn] * g[2][2], v[11][jn] * g[2][3]); o1.z = pk2(v[12][jn] * g[3][0], v[13][jn] * g[3][1]); o1.w = pk2(v[14][jn] * g[3][2], v[15][jn] * g[3][3]);
        bf16* p = d.WT + (size_t)(d.row + jn) * d.K + d.kk0;
        *(GAS u32x4*)p = o0; *(GAS u32x4*)(p + 8) = o1; }
}

DEV void phase_convert(const Params& P, const Ctx& C0, int L) {
    const Ctx C = fresh(C0);
    const int gw = C.bid * NWAVES + C.wave, NGW = C.G * NWAVES, lane = C.lane;
    constexpr int NITEMS = 2 * (2 * FF / 64) * (DM / 64) + 2 * (DM / 64) * (FF / 64) + (WIN_ROWS / 64) * (DM / 64) + (1536 / 64) * (512 / 64) + (2048 / 64) * (512 / 64)
                         + 3 * (DM / 64) * (1024 / 64) + 2 * (DM / 64) * (DM / 64) + (DM / 64) * (PLE / 64);
    if (gw < NITEMS) {
        f32x4 va[16], vb[16]; CvtItem da = cvt_describe(P, C.ws, L, gw, lane), db = da; cvt_load(da, va);
        for (int it = gw;;) {
            const int itb = it + NGW; const bool hb = itb < NITEMS;
            if (hb) { db = cvt_describe(P, C.ws, L, itb, lane); cvt_load(db, vb); }
            cvt_store(da, va); if (!hb) break;
            const int ita = itb + NGW; const bool ha = ita < NITEMS;
            if (ha) { da = cvt_describe(P, C.ws, L, ita, lane); cvt_load(da, va); }
            cvt_store(db, vb); if (!ha) break;
            it = ita;
        }
    }
    { const float* p = P.in[I_P] + (size_t)L * M * PLE; bf16* PB = (bf16*)(C.ws + WS_PB);
      const int gt = C.bid * 512 + C.tid, NGT = C.G * 512;
      for (int i = gt; i < M * PLE / 8; i += NGT) { const f32x4 a = *(const f32x4*)(p + (size_t)i * 8), b = *(const f32x4*)(p + (size_t)i * 8 + 4);
          u32x4 o; o.x = pk2(a[0], a[1]); o.y = pk2(a[2], a[3]); o.z = pk2(b[0], b[1]); o.w = pk2(b[2], b[3]); *(u32x4*)(PB + (size_t)i * 8) = o; } }
    if (L == 0) {
        const float* x = P.in[I_X]; bf16* HB = (bf16*)(C.ws + WS_HB0); u64* hss = (u64*)(C.ws + OFF_HSS);
        for (int m = gw; m < M; m += NGW) { float s = 0.f;
#pragma unroll
            for (int j = 0; j < 4; ++j) { const size_t off = (size_t)m * DM + j * 512 + lane * 8; const f32x4 a = *(const f32x4*)(x + off), b = *(const f32x4*)(x + off + 4);
                u32x4 o; o.x = pk2(a[0], a[1]); o.y = pk2(a[2], a[3]); o.z = pk2(b[0], b[1]); o.w = pk2(b[2], b[3]); *(u32x4*)(HB + off) = o;
                s += a[0] * a[0] + a[1] * a[1] + a[2] * a[2] + a[3] * a[3] + b[0] * b[0] + b[1] * b[1] + b[2] * b[2] + b[3] * b[3]; }
            s = wave_sum(s, lane); if (lane == 0) hss[m] = (u64)(s * 4294967296.f); }
    }
}

DEV void rope_tables(const Params& P, const Ctx& C0) {
    const Ctx C = fresh(C0);
        const int* pos = (const int*)P.in[I_POS]; float* COS = (float*)(C.ws + WS_COS); float* SIN = (float*)(C.ws + WS_SIN);
        const int gt = C.bid * 512 + C.tid, NGT = C.G * 512;
        for (int i = gt; i < M * 32; i += NGT) { const int m = i >> 5, j = i & 31; const double ang = (double)pos[m] * INVF[j];
            const double n = rint(ang * 0.6366197723675814); double r = fma(-n, 1.5707963267948966, ang); r = fma(-n, 6.123233995736766e-17, r);
            const double r2 = r * r;
            double sn = 1.0 / 6227020800.0; sn = fma(sn, r2, -1.0 / 39916800.0); sn = fma(sn, r2, 1.0 / 362880.0); sn = fma(sn, r2, -1.0 / 5040.0); sn = fma(sn, r2, 1.0 / 120.0); sn = fma(sn, r2, -1.0 / 6.0); sn = fma(sn * r2, r, r);
            double cs = -1.0 / 87178291200.0; cs = fma(cs, r2, 1.0 / 479001600.0); cs = fma(cs, r2, -1.0 / 3628800.0); cs = fma(cs, r2, 1.0 / 40320.0); cs = fma(cs, r2, -1.0 / 720.0); cs = fma(cs, r2, 1.0 / 24.0); cs = fma(cs, r2, -0.5); cs = fma(cs, r2, 1.0);
            const int q = ((int)n) & 3; const double so = (q == 0) ? sn : (q == 1) ? cs : (q == 2) ? -sn : -cs; const double co = (q == 0) ? cs : (q == 1) ? -sn : (q == 2) ? -cs : sn;
            COS[i] = (float)co; SIN[i] = (float)so; }
}
namespace att {
constexpr int NW = 8, QBLK = 32, KVBLK = 64;
constexpr float SCALE = 0.07216878364870323f;
constexpr float THR = 8.f;
constexpr int LDQ = 192, LDK = 128, LDR = 64, LDO = 1024;
constexpr int SHM_V = KVBLK * 128 * 2, SHM_K = KVBLK * 128 * 2, SHM_R = KVBLK * 64 * 2;
constexpr int NBUF = 3;
constexpr int OFF_V = 0, OFF_K = NBUF * SHM_V, OFF_R = OFF_K + NBUF * SHM_K, OFF_WS = OFF_R + NBUF * SHM_R, SHM_ATTN = OFF_WS + NW * 64 * 4;
#define KSWZ(row, colB) ((row) * 256 + ((colB) ^ (((row) & 7) << 4)))
#define RSWZ(row, colB) ((row) * 128 + ((colB) ^ (((row) & 7) << 4)))
#define SBAR() __builtin_amdgcn_sched_barrier(0)
DEV int crow(int r, int hi) { return (r & 3) + 8 * (r >> 2) + 4 * hi; }
DEV unsigned cvtpk(float lo, float hi) { return pk2(lo, hi); }
DEV bf16x8 ld8(const bf16* p) { return *(const GAS bf16x8*)p; }

template <int ST> DEV void partialSM_part(f32x16& p0, f32x16& p1, float& m_reg, float& mn, float& alpha, float& pmax, float& mnC) {
  constexpr float C = SCALE * 1.4426950408889634f;
  if constexpr (ST == 0) {
    pmax = p0[0];
#pragma unroll
    for (int r = 1; r < 16; ++r) pmax = fmaxf(pmax, p0[r]);
#pragma unroll
    for (int r = 0; r < 16; ++r) pmax = fmaxf(pmax, p1[r]);
    { auto rr = __builtin_amdgcn_permlane32_swap(__float_as_uint(pmax), __float_as_uint(pmax), false, false);
      pmax = fmaxf(__uint_as_float(rr[0]), __uint_as_float(rr[1])); }
  } else if constexpr (ST == 1) {
    if (__builtin_expect(__all(pmax - m_reg <= THR / SCALE), 1)) { mn = m_reg; alpha = 1.f; }
    else { mn = fmaxf(m_reg, pmax); alpha = __builtin_amdgcn_exp2f((m_reg - mn) * C); m_reg = mn; }
    mnC = -mn * C;
#pragma unroll
    for (int r = 0; r < 16; ++r) p0[r] = fmaf(p0[r], C, mnC);
#pragma unroll
    for (int r = 0; r < 8; ++r) p1[r] = fmaf(p1[r], C, mnC);
  } else if constexpr (ST == 2) {
#pragma unroll
    for (int r = 8; r < 16; ++r) p1[r] = fmaf(p1[r], C, mnC);
#pragma unroll
    for (int r = 0; r < 6; ++r) p0[r] = __builtin_amdgcn_exp2f(p0[r]);
    asm volatile("" : "+v"(p0));
  } else {
#pragma unroll
    for (int r = 6; r < 16; ++r) p0[r] = __builtin_amdgcn_exp2f(p0[r]);
    asm volatile("" : "+v"(p0));
  }
}
DEV void partialSM(f32x16& p0, f32x16& p1, float& m_reg, float& mn, float& alpha) {
  float pmax, mnC;
  partialSM_part<0>(p0, p1, m_reg, mn, alpha, pmax, mnC); partialSM_part<1>(p0, p1, m_reg, mn, alpha, pmax, mnC);
  partialSM_part<2>(p0, p1, m_reg, mn, alpha, pmax, mnC); partialSM_part<3>(p0, p1, m_reg, mn, alpha, pmax, mnC);
}
struct FinSM { float ps; };
#define PK4(P, BASE, OUT) do { u32x4 w = {cvtpk(P[BASE + 0], P[BASE + 1]), cvtpk(P[BASE + 2], P[BASE + 3]), cvtpk(P[BASE + 4], P[BASE + 5]), cvtpk(P[BASE + 6], P[BASE + 7])}; \
    OUT = *reinterpret_cast<bf16x8*>(&w); } while (0)
template <int ST> DEV void finishSM_part(f32x16& p0, f32x16& p1, float alpha, float& l_reg, float& ps, bf16x8& pa0, bf16x8& pa1, bf16x8& pa2, bf16x8& pa3) {
  if constexpr (ST < 8) {
    p1[2 * ST] = __builtin_amdgcn_exp2f(p1[2 * ST]); p1[2 * ST + 1] = __builtin_amdgcn_exp2f(p1[2 * ST + 1]);
    if constexpr (ST == 0) ps = p0[0] + p0[1]; else ps += p0[2 * ST] + p0[2 * ST + 1];
    if constexpr (ST > 0) ps += p1[2 * ST - 2] + p1[2 * ST - 1];
  } else if constexpr (ST == 8) {
    ps += p1[14] + p1[15];
    { auto rr = __builtin_amdgcn_permlane32_swap(__float_as_uint(ps), __float_as_uint(ps), false, false);
      ps = __uint_as_float(rr[0]) + __uint_as_float(rr[1]); }
    l_reg = l_reg * alpha + ps;
    PK4(p0, 0, pa0);
  } else if constexpr (ST == 9) { PK4(p0, 8, pa1); }
  else if constexpr (ST == 10) { PK4(p1, 0, pa2); }
  else { PK4(p1, 8, pa3); }
}
DEV void finishSM(f32x16& p0, f32x16& p1, float alpha, float& l_reg, bf16x8& pa0, bf16x8& pa1, bf16x8& pa2, bf16x8& pa3) {
  float ps;
  finishSM_part<0>(p0, p1, alpha, l_reg, ps, pa0, pa1, pa2, pa3); finishSM_part<1>(p0, p1, alpha, l_reg, ps, pa0, pa1, pa2, pa3); finishSM_part<2>(p0, p1, alpha, l_reg, ps, pa0, pa1, pa2, pa3);
  finishSM_part<3>(p0, p1, alpha, l_reg, ps, pa0, pa1, pa2, pa3); finishSM_part<4>(p0, p1, alpha, l_reg, ps, pa0, pa1, pa2, pa3); finishSM_part<5>(p0, p1, alpha, l_reg, ps, pa0, pa1, pa2, pa3);
  finishSM_part<6>(p0, p1, alpha, l_reg, ps, pa0, pa1, pa2, pa3); finishSM_part<7>(p0, p1, alpha, l_reg, ps, pa0, pa1, pa2, pa3); finishSM_part<8>(p0, p1, alpha, l_reg, ps, pa0, pa1, pa2, pa3);
  finishSM_part<9>(p0, p1, alpha, l_reg, ps, pa0, pa1, pa2, pa3); finishSM_part<10>(p0, p1, alpha, l_reg, ps, pa0, pa1, pa2, pa3); finishSM_part<11>(p0, p1, alpha, l_reg, ps, pa0, pa1, pa2, pa3);
}
template <int OFF> DEV bf16x8 rd128(int a) { bf16x8 r; asm volatile("ds_read_b128 %0, %1 offset:%2" : "=&v"(r) : "v"(a), "i"(OFF) : "memory"); return r; }
DEV void qkt(f32x16& p0, f32x16& p1, int ka0, int ra0, int kof, int rof, const bf16x8* qr) {
  const int ka = ka0 + kof, ra = ra0 + rof;
  p0 = f32x16{}; p1 = f32x16{};
  bf16x8 f[2][2];
#define RDK(d, s) do { const int a_ = ka ^ ((d) * 32); f[s][0] = rd128<0>(a_); f[s][1] = rd128<8192>(a_); } while (0)
#define RDR(d, s) do { const int a_ = ra ^ ((d) * 32); f[s][0] = rd128<0>(a_); f[s][1] = rd128<4096>(a_); } while (0)
#define WAIT2(s) asm volatile("s_waitcnt lgkmcnt(2)" : "+v"(f[s][0]), "+v"(f[s][1]) :: "memory")
#define WAIT0(s) asm volatile("s_waitcnt lgkmcnt(0)" : "+v"(f[s][0]), "+v"(f[s][1]) :: "memory")
#define MMA(d, s) do { p0 = __builtin_amdgcn_mfma_f32_32x32x16_bf16(f[s][0], qr[d], p0, 0, 0, 0); p1 = __builtin_amdgcn_mfma_f32_32x32x16_bf16(f[s][1], qr[d], p1, 0, 0, 0); } while (0)
  RDK(0, 0);
  RDK(1, 1); WAIT2(0); MMA(0, 0);
  RDK(2, 0); WAIT2(1); MMA(1, 1);
  RDK(3, 1); WAIT2(0); MMA(2, 0);
  RDK(4, 0); WAIT2(1); MMA(3, 1);
  RDK(5, 1); WAIT2(0); MMA(4, 0);
  RDK(6, 0); WAIT2(1); MMA(5, 1);
  RDK(7, 1); WAIT2(0); MMA(6, 0);
  RDR(0, 0); WAIT2(1); MMA(7, 1);
  RDR(1, 1); WAIT2(0); MMA(8, 0);
  RDR(2, 0); WAIT2(1); MMA(9, 1);
  RDR(3, 1); WAIT2(0); MMA(10, 0);
  WAIT0(1); MMA(11, 1);
#undef RDK
#undef RDR
#undef WAIT2
#undef WAIT0
#undef MMA
}
DEV void qkt_fin(f32x16& p0, f32x16& p1, int ka0, int ra0, int kof, int rof, const bf16x8* qr,
                 f32x16& f0, f32x16& f1, float alpha, float& l_reg, bf16x8& pa0, bf16x8& pa1, bf16x8& pa2, bf16x8& pa3) {
  const int ka = ka0 + kof, ra = ra0 + rof;
  p0 = f32x16{}; p1 = f32x16{};
  bf16x8 f[2][2]; float ps;
#define RDK(d, s) do { const int a_ = ka ^ ((d) * 32); f[s][0] = rd128<0>(a_); f[s][1] = rd128<8192>(a_); } while (0)
#define RDR(d, s) do { const int a_ = ra ^ ((d) * 32); f[s][0] = rd128<0>(a_); f[s][1] = rd128<4096>(a_); } while (0)
#define WAIT2(s) asm volatile("s_waitcnt lgkmcnt(2)" : "+v"(f[s][0]), "+v"(f[s][1]) :: "memory")
#define WAIT0(s) asm volatile("s_waitcnt lgkmcnt(0)" : "+v"(f[s][0]), "+v"(f[s][1]) :: "memory")
#define MMA(d, s) do { p0 = __builtin_amdgcn_mfma_f32_32x32x16_bf16(f[s][0], qr[d], p0, 0, 0, 0); p1 = __builtin_amdgcn_mfma_f32_32x32x16_bf16(f[s][1], qr[d], p1, 0, 0, 0); \
    SBAR(); finishSM_part<d>(f0, f1, alpha, l_reg, ps, pa0, pa1, pa2, pa3); SBAR(); } while (0)
  RDK(0, 0);
  RDK(1, 1); WAIT2(0); MMA(0, 0);
  RDK(2, 0); WAIT2(1); MMA(1, 1);
  RDK(3, 1); WAIT2(0); MMA(2, 0);
  RDK(4, 0); WAIT2(1); MMA(3, 1);
  RDK(5, 1); WAIT2(0); MMA(4, 0);
  RDK(6, 0); WAIT2(1); MMA(5, 1);
  RDK(7, 1); WAIT2(0); MMA(6, 0);
  RDR(0, 0); WAIT2(1); MMA(7, 1);
  RDR(1, 1); WAIT2(0); MMA(8, 0);
  RDR(2, 0); WAIT2(1); MMA(9, 1);
  RDR(3, 1); WAIT2(0); MMA(10, 0);
  WAIT0(1); MMA(11, 1);
#undef RDK
#undef RDR
#undef WAIT2
#undef WAIT0
#undef MMA
}
DEV int v_st(int k, int c) { const int kk = (k & ~0xC) | ((k & 4) << 1) | ((k & 8) >> 1); return ((kk >> 3) * 4 + (c >> 5)) * 512 + ((kk & 7) * 32 + (c & 31)) * 2; }
DEV int v_rd_base(int lane) { return ((lane & 3) << 3) | (((lane >> 2) & 3) << 6) | (((lane >> 4) & 1) << 5) | (((lane >> 5) & 1) << 8); }
constexpr int v_rd_off(int d0, int ks, int half) { return d0 * 512 + ks * 4096 + half * 2048; }
template <int OFF> DEV s16x4 tr_read(int vb) {
  s16x4 r; asm volatile("ds_read_b64_tr_b16 %0, %1 offset:%2" : "=&v"(r) : "v"(vb), "i"(OFF) : "memory"); return r;
}
template <int D0> DEV void pv_one(f32x16& od, int vb, bf16x8 pa0, bf16x8 pa1, bf16x8 pa2, bf16x8 pa3) {
  const s16x4 l0 = tr_read<v_rd_off(D0, 0, 0)>(vb), h0 = tr_read<v_rd_off(D0, 0, 1)>(vb), l1 = tr_read<v_rd_off(D0, 1, 0)>(vb), h1 = tr_read<v_rd_off(D0, 1, 1)>(vb);
  const s16x4 l2 = tr_read<v_rd_off(D0, 2, 0)>(vb), h2 = tr_read<v_rd_off(D0, 2, 1)>(vb), l3 = tr_read<v_rd_off(D0, 3, 0)>(vb), h3 = tr_read<v_rd_off(D0, 3, 1)>(vb);
  asm volatile("s_waitcnt lgkmcnt(0)" ::: "memory"); SBAR();
#define PK(L, H) (bf16x8){L[0], L[1], L[2], L[3], H[0], H[1], H[2], H[3]}
  od = __builtin_amdgcn_mfma_f32_32x32x16_bf16(pa0, PK(l0, h0), od, 0, 0, 0);
  od = __builtin_amdgcn_mfma_f32_32x32x16_bf16(pa1, PK(l1, h1), od, 0, 0, 0);
  od = __builtin_amdgcn_mfma_f32_32x32x16_bf16(pa2, PK(l2, h2), od, 0, 0, 0);
  od = __builtin_amdgcn_mfma_f32_32x32x16_bf16(pa3, PK(l3, h3), od, 0, 0, 0);
#undef PK
}
DEV void pv_d0(f32x16* o, int vb, bf16x8 pa0, bf16x8 pa1, bf16x8 pa2, bf16x8 pa3) {
  pv_one<0>(o[0], vb, pa0, pa1, pa2, pa3); pv_one<1>(o[1], vb, pa0, pa1, pa2, pa3); pv_one<2>(o[2], vb, pa0, pa1, pa2, pa3); pv_one<3>(o[3], vb, pa0, pa1, pa2, pa3);
}

struct VFrag { s16x4 l0, h0, l1, h1, l2, h2, l3, h3; };
template <int D0> DEV void pv_read(VFrag& f, int vb) {
  f.l0 = tr_read<v_rd_off(D0, 0, 0)>(vb); f.h0 = tr_read<v_rd_off(D0, 0, 1)>(vb); f.l1 = tr_read<v_rd_off(D0, 1, 0)>(vb); f.h1 = tr_read<v_rd_off(D0, 1, 1)>(vb);
  f.l2 = tr_read<v_rd_off(D0, 2, 0)>(vb); f.h2 = tr_read<v_rd_off(D0, 2, 1)>(vb); f.l3 = tr_read<v_rd_off(D0, 3, 0)>(vb); f.h3 = tr_read<v_rd_off(D0, 3, 1)>(vb);
}
DEV void pv_wait(VFrag& f) {
  asm volatile("s_waitcnt lgkmcnt(0)" : "+v"(f.l0), "+v"(f.h0), "+v"(f.l1), "+v"(f.h1), "+v"(f.l2), "+v"(f.h2), "+v"(f.l3), "+v"(f.h3) :: "memory");
}
DEV void pv_mma(f32x16& od, const VFrag& f, bf16x8 pa0, bf16x8 pa1, bf16x8 pa2, bf16x8 pa3) {
#define PK(L, H) (bf16x8){L[0], L[1], L[2], L[3], H[0], H[1], H[2], H[3]}
  od = __builtin_amdgcn_mfma_f32_32x32x16_bf16(pa0, PK(f.l0, f.h0), od, 0, 0, 0);
  od = __builtin_amdgcn_mfma_f32_32x32x16_bf16(pa1, PK(f.l1, f.h1), od, 0, 0, 0);
  od = __builtin_amdgcn_mfma_f32_32x32x16_bf16(pa2, PK(f.l2, f.h2), od, 0, 0, 0);
  od = __builtin_amdgcn_mfma_f32_32x32x16_bf16(pa3, PK(f.l3, f.h3), od, 0, 0, 0);
#undef PK
}
DEV void pv_psm(f32x16* o, int vb, bf16x8 pa0, bf16x8 pa1, bf16x8 pa2, bf16x8 pa3, f32x16& q0, f32x16& q1, float& m_reg, float& mn, float& alpha) {
  VFrag fa, fb; float pmax, mnC;
  pv_read<0>(fa, vb);
  pv_wait(fa); pv_mma(o[0], fa, pa0, pa1, pa2, pa3); pv_read<1>(fb, vb); SBAR(); partialSM_part<0>(q0, q1, m_reg, mn, alpha, pmax, mnC); SBAR();
  pv_wait(fb); pv_mma(o[1], fb, pa0, pa1, pa2, pa3); pv_read<2>(fa, vb); SBAR(); partialSM_part<1>(q0, q1, m_reg, mn, alpha, pmax, mnC); SBAR();
  pv_wait(fa); pv_mma(o[2], fa, pa0, pa1, pa2, pa3); pv_read<3>(fb, vb); SBAR(); partialSM_part<2>(q0, q1, m_reg, mn, alpha, pmax, mnC); SBAR();
  pv_wait(fb); pv_mma(o[3], fb, pa0, pa1, pa2, pa3); SBAR(); partialSM_part<3>(q0, q1, m_reg, mn, alpha, pmax, mnC); SBAR();
}
DEV void attn_unit(const bf16* __restrict__ Qb, const bf16* __restrict__ Kh, const bf16* __restrict__ Vh, const bf16* __restrict__ Rh, bf16* __restrict__ Ob, int seq, char* lds, LAS unsigned char* ldsl, int tid_in) {
  int tid_ = tid_in; asm volatile("" : "+v"(tid_));
  const int tid = tid_, wid = __builtin_amdgcn_readfirstlane(tid >> 6), lane = tid & 63, r32 = lane & 31, hi = lane >> 5;
  float* ws = (float*)(lds + OFF_WS) + wid * 64; float* li_l = ws; float* al_l = ws + 32;
  if (wid >= 4) __builtin_amdgcn_s_setprio(1);
  float m_reg = -1e30f, l_reg = 0; f32x16 o[4] = {}; bf16x8 qr[12];
  const bf16* Qw = Qb + (long)(wid * QBLK + r32) * LDQ + hi * 8;
#pragma unroll
  for (int d0 = 0; d0 < 12; ++d0) qr[d0] = ld8(Qw + d0 * 16);
  const int vb0 = (int)(uintptr_t)(lds + OFF_V) + v_rd_base(lane);
  const int ka = (int)(uintptr_t)(lds + OFF_K) + r32 * 256 + ((hi * 16) ^ ((r32 & 15) << 4)), ra = (int)(uintptr_t)(lds + OFF_R) + r32 * 128 + ((hi * 16) ^ (((r32 >> 1) & 7) << 4));
  const int NT = seq / KVBLK;
#define DMA16(gp, lp) __builtin_amdgcn_global_load_lds((const unsigned*)(gp), (LAS unsigned*)(lp), 16, 0, 0)
#define DMA_SRC() const int ln_ = lane;   \
    int kof_[2], vof_[2]; _Pragma("unroll") for (int i = 0; i < 2; ++i) { const int n = 2 * wid + i; \
      { const int row = 4 * n + (ln_ >> 4), colB = ((ln_ & 15) * 16) ^ ((row & 15) << 4); kof_[i] = row * 256 + colB; } \
      { const int blk = 2 * n + (ln_ >> 5), kk = (blk >> 2) * 8 + ((ln_ & 31) >> 2), c = (blk & 3) * 32 + 8 * (ln_ & 3); vof_[i] = kk * 256 + c * 2;   } } \
    const int rrow_ = 8 * wid + (ln_ >> 3), rof_ = rrow_ * 128 + (((ln_ & 7) * 16) ^ (((rrow_ >> 1) & 7) << 4));
#define DMA_KR(t, b) do { const int tt = (t) < NT ? (t) : NT - 1; const char* kp = (const char*)Kh + (size_t)tt * (KVBLK * 256); const char* rp = (const char*)Rh + (size_t)tt * (KVBLK * 128); \
    DMA16(kp + kof_[0], ldsl + OFF_K + (b) * SHM_K + (2 * wid) * 1024); DMA16(kp + kof_[1], ldsl + OFF_K + (b) * SHM_K + (2 * wid + 1) * 1024); DMA16(rp + rof_, ldsl + OFF_R + (b) * SHM_R + wid * 1024); } while (0)
#define DMA_V(t, b) do { const int tt = (t) < NT ? (t) : NT - 1; const char* vp = (const char*)Vh + (size_t)tt * (KVBLK * 256); \
    DMA16(vp + vof_[0], ldsl + OFF_V + (b) * SHM_V + (2 * wid) * 1024); DMA16(vp + vof_[1], ldsl + OFF_V + (b) * SHM_V + (2 * wid + 1) * 1024); } while (0)
#define WAITV(n) asm volatile("s_waitcnt vmcnt(" #n ")" ::: "memory")
#define NEXTB(b) ((b) == NBUF - 1 ? 0 : (b) + 1)
#define RESC(a) do { if (__any((a) < 1.f)) { if (hi == 0) al_l[r32] = (a); asm volatile("s_waitcnt lgkmcnt(0)" ::: "memory"); \
    _Pragma("unroll") for (int d = 0; d < 4; ++d) _Pragma("unroll") for (int r = 0; r < 16; ++r) o[d][r] *= al_l[crow(r, hi)]; } } while (0)
  f32x16 pA0, pA1, pB0, pB1; float mnA, mnB, alA, alB; bf16x8 pa0, pa1, pa2, pa3;
  DMA_SRC();
  DMA_KR(0, 0); DMA_KR(1, 1); DMA_V(0, 0); DMA_KR(2, 2); DMA_V(1, 1);
  WAITV(10); __builtin_amdgcn_s_barrier(); asm volatile("" ::: "memory");
  qkt(pA0, pA1, ka, ra, 0, 0, qr); partialSM(pA0, pA1, m_reg, mnA, alA);
  int bt = 0;
#define HALF(t, X0, X1, alX, Y0, Y1, mnY, alY) do { \
    WAITV(5); __builtin_amdgcn_s_barrier(); asm volatile("" ::: "memory"); \
    const int b1 = NEXTB(bt), b2 = NEXTB(b1); \
    DMA_KR((t) + 3, bt); DMA_V((t) + 2, b2); \
    SBAR(); qkt_fin(Y0, Y1, ka, ra, b1 * SHM_K, b1 * SHM_R, qr, X0, X1, alX, l_reg, pa0, pa1, pa2, pa3); SBAR(); \
    pv_psm(o, vb0 + bt * SHM_V, pa0, pa1, pa2, pa3, Y0, Y1, m_reg, mnY, alY); \
    RESC(alY); bt = b1; } while (0)
  int t = 0;
  for (; t + 2 < NT; t += 2) {
    HALF(t, pA0, pA1, alA, pB0, pB1, mnB, alB);
    HALF(t + 1, pB0, pB1, alB, pA0, pA1, mnA, alA);
  }
  HALF(t, pA0, pA1, alA, pB0, pB1, mnB, alB);
  WAITV(0); __builtin_amdgcn_s_barrier(); asm volatile("" ::: "memory");
  finishSM(pB0, pB1, alB, l_reg, pa0, pa1, pa2, pa3); SBAR();
  pv_d0(o, vb0 + bt * SHM_V, pa0, pa1, pa2, pa3);
  if (hi == 0) li_l[r32] = l_reg; asm volatile("s_waitcnt lgkmcnt(0)" ::: "memory");
  float rli[16];
#pragma unroll
  for (int r = 0; r < 16; ++r) rli[r] = __builtin_amdgcn_rcpf(li_l[crow(r, hi)]);
  bf16* Ow = Ob + (long)(wid * QBLK) * LDO;
  LAS unsigned char* ot = ldsl + OFF_K + wid * 8192;
  { LAS unsigned char* ob = ot + hi * 1024 + r32 * 2;
#pragma unroll
    for (int r = 0; r < 16; ++r)
#pragma unroll
      for (int d0 = 0; d0 < 4; ++d0) *(LAS bf16*)(ob + ((r & 3) + 8 * (r >> 2)) * 256 + d0 * 64) = (bf16)f2bf(o[d0][r] * rli[r]); }
#pragma unroll
  for (int i = 0; i < 8; ++i) { const int c = i * 64 + lane, row = c >> 4, cc = c & 15;
    const u32x4 w = *(const LAS u32x4*)(ot + row * 256 + cc * 16); *(GAS u32x4*)(Ow + (long)row * LDO + cc * 8) = w; }
  __builtin_amdgcn_s_setprio(0);
  __syncthreads();
#undef DMA16
#undef DMA_SRC
#undef DMA_KR
#undef DMA_V
#undef WAITV
#undef NEXTB
#undef HALF
#undef RESC
}
#undef KSWZ
#undef RSWZ
}
#ifndef DBG_ML
#define DBG_ML 0
#endif
DEV f32x4 mfma16(bf16x8 a, bf16x8 b, f32x4 c) { return __builtin_amdgcn_mfma_f32_16x16x32_bf16(a, b, c, 0, 0, 0); }
DEV bf16x8 frag_row(const LAS unsigned char* T, int st, int row0, int k0, int lane) {
    return *(const LAS bf16x8*)(T + (row0 + (lane & 15)) * st + (k0 + 8 * (lane >> 4)) * 2);
}
DEV bf16x8 frag_tr(const LAS unsigned char* T, int st, int k0, int col0, int lane) {
    const int g = lane >> 4, q = (lane & 15) >> 2, p = lane & 3;
    const LAS unsigned char* a = T + (k0 + 8 * g + q) * st + (col0 + 4 * p) * 2;
    const s16x4 lo = __builtin_bit_cast(s16x4, __builtin_amdgcn_ds_read_tr16_b64_v4i16((LAS s16x4*)a));
    const s16x4 hi = __builtin_bit_cast(s16x4, __builtin_amdgcn_ds_read_tr16_b64_v4i16((LAS s16x4*)(a + 4 * st)));
    return (bf16x8){lo[0], lo[1], lo[2], lo[3], hi[0], hi[1], hi[2], hi[3]};
}
DEV bf16x8 frag_scale(bf16x8 a, float f) {
    const u32x4 w = __builtin_bit_cast(u32x4, a); u32x4 o;
    o.x = pk2(bflo(w.x) * f, bfhi(w.x) * f); o.y = pk2(bflo(w.y) * f, bfhi(w.y) * f); o.z = pk2(bflo(w.z) * f, bfhi(w.z) * f); o.w = pk2(bflo(w.w) * f, bfhi(w.w) * f);
    return __builtin_bit_cast(bf16x8, o);
}
DEV bf16x8 frag_scale8(bf16x8 a, f32x4 f0, f32x4 f1) {
    const u32x4 w = __builtin_bit_cast(u32x4, a); u32x4 o;
    o.x = pk2(bflo(w.x) * f0[0], bfhi(w.x) * f0[1]); o.y = pk2(bflo(w.y) * f0[2], bfhi(w.y) * f0[3]); o.z = pk2(bflo(w.z) * f1[0], bfhi(w.z) * f1[1]); o.w = pk2(bflo(w.w) * f1[2], bfhi(w.w) * f1[3]);
    return __builtin_bit_cast(bf16x8, o);
}
DEV bf16x8 frag_from_f32(const float* p) {
    const f32x4 a = *(const f32x4*)p, b = *(const f32x4*)(p + 4);
    u32x4 w; w.x = pk2(a[0], a[1]); w.y = pk2(a[2], a[3]); w.z = pk2(b[0], b[1]); w.w = pk2(b[2], b[3]); return __builtin_bit_cast(bf16x8, w);
}
template <bool MAXOP> DEV void wave_scan2(float x0, float x1, int lane, float& r0, float& r1, float& tot) {
    float s = MAXOP ? fmaxf(x0, x1) : x0 + x1;
#pragma unroll
    for (int o = 1; o < 64; o <<= 1) { const float t = shup(s, o, lane); if (lane >= o) s = MAXOP ? fmaxf(s, t) : s + t; }
    float e = shup(s, 1, lane); if (lane == 0) e = MAXOP ? -3.0e38f : 0.f;
    r0 = MAXOP ? fmaxf(e, x0) : e + x0; r1 = s; tot = __uint_as_float(__builtin_amdgcn_readlane(__float_as_uint(s), 63));
}

constexpr int ST128 = 272, ST256 = 528;

DEV void stage_tile(LAS unsigned char* T, int st, const bf16* g, size_t gst, int rows, int cols, float scale, int tid) {
    const int cpr = cols >> 3, n = rows * cpr;
    for (int i = tid; i < n; i += 512) { const int r = i / cpr, c = i - r * cpr; u32x4 w = *(const u32x4*)(g + (size_t)r * gst + c * 8);
        if (scale != 1.f) { float v[8]; unpack8(w, v);
#pragma unroll
            for (int e = 0; e < 8; ++e) v[e] *= scale; w = pack8(v); }
        *(LAS u32x4*)(T + r * st + c * 16) = w; }
}
template <int COLS> DEV void stage_conv(LAS unsigned char* T, int st, const bf16* zin_b  , int s0, int zcol0, int ch0, const float* cw, const float* cb, int tid) {
    constexpr int CPR = COLS / 8, RPT = 128 * CPR / 512;
    const int c = tid % CPR, r0 = (tid / CPR) * RPT;
    f32x4 w[5][2], bias[2];
#pragma unroll
    for (int j = 0; j < 5; ++j) { w[j][0] = *(const GAS f32x4*)(cw + j * 1536 + ch0 + c * 8); w[j][1] = *(const GAS f32x4*)(cw + j * 1536 + ch0 + c * 8 + 4); }
    bias[0] = *(const GAS f32x4*)(cb + ch0 + c * 8); bias[1] = *(const GAS f32x4*)(cb + ch0 + c * 8 + 4);
    u32x4 raw[RPT + 4];
#pragma unroll
    for (int k = 0; k < RPT + 4; ++k) { const int s = s0 + r0 + k - 2; raw[k] = (u32x4){0u, 0u, 0u, 0u};
        if (s >= 0 && s < SEQ) raw[k] = *(const GAS u32x4*)(zin_b + (size_t)s * ZW + zcol0 + c * 8); }
#pragma unroll
    for (int k = 0; k < RPT; ++k) { float acc[8];
#pragma unroll
        for (int e = 0; e < 4; ++e) { acc[e] = bias[0][e]; acc[4 + e] = bias[1][e]; }
#pragma unroll
        for (int j = 0; j < 5; ++j) { float v[8]; unpack8(raw[k + j], v);
#pragma unroll
            for (int e = 0; e < 4; ++e) { acc[e] += v[e] * w[j][0][e]; acc[4 + e] += v[4 + e] * w[j][1][e]; } }
#pragma unroll
        for (int e = 0; e < 8; ++e) acc[e] = siluf_(acc[e]);
        *(LAS u32x4*)(T + (r0 + k) * st + c * 16) = pack8(acc); }
}

DEV void mlstm_state_unit(const Params& P, const Ctx& C0, int L, int unit) {
    const Ctx C = fresh(C0);
    const int b = unit >> 8, h = (unit >> 6) & 3, ch = unit & 63, tid = C.tid, lane = C.lane, wave = C.wave, fq = lane >> 4;
    const size_t tok0 = (size_t)b * SEQ + ch * 128;
    const bf16* ZIN = (const bf16*)(C.ws + WS_ZIN); const float* SMALL = (const float*)(C.ws + WS_SMALL);
    float* misc = (float*)(C.ws + WS_MISC);
    LAS unsigned char* KS = C.lds; LAS unsigned char* VS = C.lds + 128 * ST128; LAS float* EE = (LAS float*)(C.lds + 128 * ST128 + 128 * ST256);
    if (wave < 2) { const int d = wave, idx = ((b * 4 + h) * 2 + d) * 64 + ch;
        const float big = P.in[I_BIG][L * 8 + d * 4 + h], bfg = P.in[I_BFG][L * 8 + d * 4 + h];
        const int j0 = 2 * lane, j1 = j0 + 1, i0 = d ? 127 - j0 : j0, i1 = d ? 127 - j1 : j1;
        const float li0 = SMALL[(tok0 + i0) * SMW + d * 4 + h] + big, li1 = SMALL[(tok0 + i1) * SMW + d * 4 + h] + big;
        const float lf0 = logsigf_(SMALL[(tok0 + i0) * SMW + 8 + d * 4 + h] + bfg), lf1 = logsigf_(SMALL[(tok0 + i1) * SMW + 8 + d * 4 + h] + bfg);
        float b0, b1, g; wave_scan2<false>(lf0, lf1, lane, b0, b1, g);
        const float w0 = g - b0 + li0, w1 = g - b1 + li1; const float m = wave_max(fmaxf(w0, w1), lane);
        EE[d * 128 + i0] = __expf(w0 - m); EE[d * 128 + i1] = __expf(w1 - m);
        if (lane == 0) { misc[OFF_MLOC / 4 + idx] = m; misc[OFF_MG / 4 + idx] = g; }
    }
    stage_tile(KS, ST128, ZIN + tok0 * ZW + ZC_AK + h * 128, ZW, 128, 128, 0.08838834764831845f, tid);
    stage_tile(VS, ST256, ZIN + tok0 * ZW + ZC_AV + h * 256, ZW, 128, 256, 1.f, tid);
    __syncthreads();
    {
        const int dk = tid >> 2, part = tid & 3; float s0 = 0.f, s1 = 0.f;
#pragma unroll 8
        for (int i = 0; i < 32; ++i) { const int r = part * 32 + i; const float kv = bf2f(*(const LAS unsigned short*)(KS + r * ST128 + dk * 2)); s0 += kv * EE[r]; s1 += kv * EE[128 + r]; }
        s0 += shx(s0, 1, lane); s0 += shx(s0, 2, lane); s1 += shx(s1, 1, lane); s1 += shx(s1, 2, lane);
        if (part == 0) { const int idx0 = ((b * 4 + h) * 2) * 64 + ch; misc[OFF_NLOC / 4 + (size_t)idx0 * 128 + dk] = s0; misc[OFF_NLOC / 4 + (size_t)(idx0 + 64) * 128 + dk] = s1; } }
    for (int d = 0; d < 2; ++d) {
        const int idx = ((b * 4 + h) * 2 + d) * 64 + ch;
        f32x4 acc[8][2];
#pragma unroll
        for (int a = 0; a < 8; ++a) { acc[a][0] = (f32x4){0.f, 0.f, 0.f, 0.f}; acc[a][1] = (f32x4){0.f, 0.f, 0.f, 0.f}; }
#pragma unroll 1
        for (int ks = 0; ks < 4; ++ks) { const bf16x8 bv0 = frag_tr(VS, ST256, 32 * ks, 32 * wave, lane), bv1 = frag_tr(VS, ST256, 32 * ks, 32 * wave + 16, lane);
            const f32x4 e0 = *(const LAS f32x4*)(EE + d * 128 + 32 * ks + 8 * fq), e1 = *(const LAS f32x4*)(EE + d * 128 + 32 * ks + 8 * fq + 4);
#pragma unroll
            for (int kt = 0; kt < 8; ++kt) { const bf16x8 a = frag_scale8(frag_tr(KS, ST128, 32 * ks, 16 * kt, lane), e0, e1); acc[kt][0] = mfma16(a, bv0, acc[kt][0]); acc[kt][1] = mfma16(a, bv1, acc[kt][1]); } }
        bf16* CL = (bf16*)(C.ws + WS_CLOC) + (size_t)idx * 32768;
#pragma unroll
        for (int kt = 0; kt < 8; ++kt)
#pragma unroll
            for (int nt = 0; nt < 2; ++nt) { u32x2 w; w.x = pk2(acc[kt][nt][0], acc[kt][nt][1]); w.y = pk2(acc[kt][nt][2], acc[kt][nt][3]);
                *(GAS u32x2*)(CL + (size_t)(32 * wave + 16 * nt + (lane & 15)) * 128 + 16 * kt + 4 * (lane >> 4)) = w; }
    }
    __syncthreads();
}

DEV void mlstm_scan(const Ctx& C0) {
    const Ctx C = fresh(C0);
    float* misc = (float*)(C.ws + WS_MISC); const float* MLOC = misc + OFF_MLOC / 4; const float* MG = misc + OFF_MG / 4; float* M0 = misc + OFF_M0 / 4; float* NL = misc + OFF_NLOC / 4;
    bf16* CL = (bf16*)(C.ws + WS_CLOC);
    const int nthreads = C.G * 512;
    for (int t = C.bid * 512 + C.tid; t < 16 * 8192; t += nthreads) {
        const int chain = t >> 13, e4 = t & 8191, d = chain & 1; const bool hasn = e4 < 32;
        f32x4 st = (f32x4){0.f, 0.f, 0.f, 0.f}, sn = (f32x4){0.f, 0.f, 0.f, 0.f}; float m = 0.f;
        bf16* base = CL + (size_t)chain * 64 * 32768 + e4 * 4; float* nbase = NL + (size_t)chain * 64 * 128 + (e4 & 31) * 4;
#pragma unroll 1
        for (int s8 = 0; s8 < 64; s8 += 32) { u32x2 x[32];
#pragma unroll
            for (int k = 0; k < 32; ++k) { const int ch = d ? 63 - (s8 + k) : s8 + k; x[k] = *(const GAS u32x2*)(base + (size_t)ch * 32768); }
#pragma unroll
            for (int hf = 0; hf < 2; ++hf) { f32x4 xn[16];
#pragma unroll
                for (int k = 0; k < 16; ++k) { const int ch = d ? 63 - (s8 + 16 * hf + k) : s8 + 16 * hf + k; xn[k] = (f32x4){0.f, 0.f, 0.f, 0.f}; if (hasn) xn[k] = *(const GAS f32x4*)(nbase + (size_t)ch * 128); }
#pragma unroll
                for (int k = 0; k < 16; ++k) { const int ch = d ? 63 - (s8 + 16 * hf + k) : s8 + 16 * hf + k; const float g = MG[chain * 64 + ch], ml = MLOC[chain * 64 + ch];
                    u32x2 w; w.x = pk2(st[0], st[1]); w.y = pk2(st[2], st[3]); *(GAS u32x2*)(base + (size_t)ch * 32768) = w;
                    if (hasn) { *(GAS f32x4*)(nbase + (size_t)ch * 128) = sn; if (e4 == 0) M0[chain * 64 + ch] = m; }
                    const float mn = fmaxf(g + m, ml), ap = __expf(g + m - mn), al = __expf(ml - mn);
                    const u32x2 xv = x[16 * hf + k];
                    st = st * ap + (f32x4){bflo(xv.x), bfhi(xv.x), bflo(xv.y), bfhi(xv.y)} * al; sn = sn * ap + xn[k] * al; m = mn; } } }
    }
}

DEV void mlstm_out_unit(const Params& P, const Ctx& C0, int L, int unit) {
    const Ctx C = fresh(C0);
    const int b = unit >> 8, h = (unit >> 6) & 3, ch = unit & 63, tid = C.tid, lane = C.lane, wave = C.wave, fr = lane & 15, fq = lane >> 4;
    const size_t tok0 = (size_t)b * SEQ + ch * 128;
    const bf16* ZIN = (const bf16*)(C.ws + WS_ZIN); const float* SMALL = (const float*)(C.ws + WS_SMALL); const float* misc = (const float*)(C.ws + WS_MISC);
    LAS unsigned char* QS = C.lds; LAS unsigned char* KP = C.lds + 128 * ST128; LAS unsigned char* VS = C.lds + 2 * 128 * ST128;
    LAS float* vec = (LAS float*)(C.lds + 2 * 128 * ST128 + 128 * ST256);
    LAS float* AVb = vec, *MXb = vec + 256, *EIb = vec + 512, *FLb = vec + 768, *QNb = vec + 1024, *FQ = vec + 1280, *SSQ = vec + 1408;
    if (wave < 2) {
        const int d = wave, idx = ((b * 4 + h) * 2 + d) * 64 + ch;
        const float big = P.in[I_BIG][L * 8 + d * 4 + h], bfg = P.in[I_BFG][L * 8 + d * 4 + h], m0 = misc[OFF_M0 / 4 + idx];
        const int j0 = 2 * lane, j1 = j0 + 1, i0 = d ? 127 - j0 : j0, i1 = d ? 127 - j1 : j1;
        const float li0 = SMALL[(tok0 + i0) * SMW + d * 4 + h] + big, li1 = SMALL[(tok0 + i1) * SMW + d * 4 + h] + big;
        const float lf0 = logsigf_(SMALL[(tok0 + i0) * SMW + 8 + d * 4 + h] + bfg), lf1 = logsigf_(SMALL[(tok0 + i1) * SMW + 8 + d * 4 + h] + bfg);
        float b0, b1, g; wave_scan2<false>(lf0, lf1, lane, b0, b1, g);
        const float a0 = li0 - b0, a1 = li1 - b1; float p0, p1, pt; wave_scan2<true>(a0, a1, lane, p0, p1, pt);
        const float x0 = fmaxf(m0, p0), x1 = fmaxf(m0, p1);
        LAS float* AV = AVb + d * 128, *MX = MXb + d * 128, *EI = EIb + d * 128, *FL = FLb + d * 128;
        AV[i0] = a0; AV[i1] = a1; MX[i0] = x0; MX[i1] = x1; EI[i0] = __expf(m0 - x0); EI[i1] = __expf(m0 - x1); FL[i0] = __expf(-(b0 + x0)); FL[i1] = __expf(-(b1 + x1));
    }
    stage_tile(QS, ST128, ZIN + tok0 * ZW + ZC_AQ + h * 128, ZW, 128, 128, 1.f, tid);
    stage_tile(KP, ST128, ZIN + tok0 * ZW + ZC_AK + h * 128, ZW, 128, 128, 0.08838834764831845f, tid);
    stage_tile(VS, ST256, ZIN + tok0 * ZW + ZC_AV + h * 256, ZW, 128, 256, 1.f, tid);
    __syncthreads();
    f32x4 sreg[8];
#pragma unroll
    for (int st = 0; st < 8; ++st) sreg[st] = (f32x4){0.f, 0.f, 0.f, 0.f};
#pragma unroll
    for (int ks = 0; ks < 4; ++ks) { const bf16x8 bq = frag_row(QS, ST128, 16 * wave, 32 * ks, lane);
#pragma unroll
        for (int st = 0; st < 8; ++st) sreg[st] = mfma16(frag_row(KP, ST128, 16 * st, 32 * ks, lane), bq, sreg[st]); }
#pragma unroll
    for (int d = 0; d < 2; ++d) {
        const int idx = ((b * 4 + h) * 2 + d) * 64 + ch, r = tid >> 2, part = tid & 3; const float* n0 = misc + OFF_NLOC / 4 + (size_t)idx * 128 + part * 32; float s = 0.f;
#pragma unroll
        for (int c = 0; c < 4; ++c) { float v[8]; unpack8(*(const LAS u32x4*)(QS + r * ST128 + (part * 32 + c * 8) * 2), v);
            const f32x4 n0a = *(const GAS f32x4*)(n0 + c * 8), n0b = *(const GAS f32x4*)(n0 + c * 8 + 4);
#pragma unroll
            for (int e = 0; e < 4; ++e) s += v[e] * n0a[e] + v[4 + e] * n0b[e]; }
        s += shx(s, 1, lane); s += shx(s, 2, lane); if (part == 0) QNb[d * 128 + r] = s;
    }
    f32x4 acc[8][2];
#pragma unroll
    for (int a = 0; a < 8; ++a) { acc[a][0] = (f32x4){0.f, 0.f, 0.f, 0.f}; acc[a][1] = (f32x4){0.f, 0.f, 0.f, 0.f}; }
    const int t = 16 * wave + fr;
    for (int d = 0; d < 2; ++d) {
        const int idx = ((b * 4 + h) * 2 + d) * 64 + ch;
        const LAS float* AV = AVb + d * 128; const LAS float* MX = MXb + d * 128; const LAS float* EI = EIb + d * 128; const LAS float* FL = FLb + d * 128; const LAS float* QN = QNb + d * 128;
        const bf16* C0 = (const bf16*)(C.ws + WS_CLOC) + (size_t)idx * 32768;
        bf16x8 bc[4][2];
#pragma unroll
        for (int ks = 0; ks < 4; ++ks)
#pragma unroll
            for (int nt = 0; nt < 2; ++nt) bc[ks][nt] = *(const GAS bf16x8*)(C0 + (size_t)(32 * wave + 16 * nt + fr) * 128 + 32 * ks + 8 * fq);
        __syncthreads();
        {
            const float mx = MX[t]; float rs = 0.f; f32x4 pr[8];
#pragma unroll
            for (int st = 0; st < 8; ++st) { const f32x4 av = *(const LAS f32x4*)(AV + 16 * st + 4 * fq);
#pragma unroll
                for (int i = 0; i < 4; ++i) { const int s = 16 * st + 4 * fq + i; const bool valid = d ? (s >= t) : (s <= t);
                    const float dd = valid ? __expf(av[i] - mx) : 0.f; pr[st][i] = sreg[st][i] * dd; rs += pr[st][i]; } }
            rs = xsum32(xsum16(rs));
            const float den = rs + EI[t] * QN[t]; const float inv = __builtin_amdgcn_rcpf(fmaxf(fabsf(den), FL[t]));
            if (fq == 0) FQ[t] = EI[t] * inv;
#pragma unroll
            for (int st = 0; st < 8; ++st) { u32x2 w; w.x = pk2(pr[st][0] * inv, pr[st][1] * inv); w.y = pk2(pr[st][2] * inv, pr[st][3] * inv);
                *(LAS u32x2*)(KP + t * ST128 + (16 * st + 4 * fq) * 2) = w; }
        }
        __syncthreads();
#pragma unroll 1
        for (int ks = 0; ks < 4; ++ks) { const bf16x8 bv0 = frag_tr(VS, ST256, 32 * ks, 32 * wave, lane), bv1 = frag_tr(VS, ST256, 32 * ks, 32 * wave + 16, lane);
#pragma unroll
            for (int tt = 0; tt < 8; ++tt) { const bf16x8 a = frag_row(KP, ST128, 16 * tt, 32 * ks, lane); if (!(DBG_ML & 1) && !((DBG_ML >> (2 + d)) & 1)) { acc[tt][0] = mfma16(a, bv0, acc[tt][0]); acc[tt][1] = mfma16(a, bv1, acc[tt][1]); } } }
#pragma unroll
        for (int ks = 0; ks < 4; ++ks) {
#pragma unroll
            for (int tt = 0; tt < 8; ++tt) { const bf16x8 a = frag_scale(frag_row(QS, ST128, 16 * tt, 32 * ks, lane), FQ[16 * tt + fr]); if (!(DBG_ML & 2) && !((DBG_ML >> (2 + d)) & 1)) { acc[tt][0] = mfma16(a, bc[ks][0], acc[tt][0]); acc[tt][1] = mfma16(a, bc[ks][1], acc[tt][1]); }
                if (tt & 1) __builtin_amdgcn_sched_barrier(0); } }
    }
#pragma unroll
    for (int tt = 0; tt < 8; ++tt)
#pragma unroll
        for (int i = 0; i < 4; ++i) { float s = acc[tt][0][i] * acc[tt][0][i] + acc[tt][1][i] * acc[tt][1][i];
            s += shx(s, 1, lane); s += shx(s, 2, lane); s += shx(s, 4, lane); s += shx(s, 8, lane);
            if (fr == 0) SSQ[wave * 128 + 16 * tt + 4 * fq + i] = s; }
    __syncthreads();
    if (tid < 128) { float s = 0.f;
#pragma unroll
        for (int w = 0; w < 8; ++w) s += SSQ[w * 128 + tid];
        FQ[tid] = rsqrtf(s * (1.f / 256.f) + EPS); }
    __syncthreads();
#pragma unroll
    for (int tt = 0; tt < 8; ++tt)
#pragma unroll
        for (int i = 0; i < 4; ++i) { const int tr = 16 * tt + 4 * fq + i; const float rstd = FQ[tr];
#pragma unroll
            for (int nt = 0; nt < 2; ++nt) *(LAS unsigned short*)(VS + tr * ST256 + (32 * wave + 16 * nt + fr) * 2) = (unsigned short)f2bf(acc[tt][nt][i] * rstd); }
    __syncthreads();
    {   const float* ng = P.in[I_MLN] + L * 1024 + h * 256; bf16* YA = (bf16*)(C.ws + WS_Y);
        u32x4 og[8];
#pragma unroll
        for (int k = 0; k < 8; ++k) { const int c = tid + 512 * k, tr = c >> 5, c8 = (c & 31) * 8; og[k] = *(const GAS u32x4*)(ZIN + (tok0 + tr) * ZW + ZC_AO + h * 256 + c8); }
#pragma unroll
        for (int k = 0; k < 8; ++k) { const int c = tid + 512 * k, tr = c >> 5, c8 = (c & 31) * 8; float hv[8], gv[8], o[8];
            unpack8(*(const LAS u32x4*)(VS + tr * ST256 + c8 * 2), hv); unpack8(og[k], gv);
            const f32x4 n0 = *(const GAS f32x4*)(ng + c8), n1 = *(const GAS f32x4*)(ng + c8 + 4);
#pragma unroll
            for (int e = 0; e < 4; ++e) { o[e] = sigmoidf_(gv[e]) * hv[e] * n0[e]; o[4 + e] = sigmoidf_(gv[4 + e]) * hv[4 + e] * n1[e]; }
            *(GAS u32x4*)(YA + (tok0 + tr) * 1024 + h * 256 + c8) = pack8(o); }
    }
    __syncthreads();
}
#ifndef DBG_SSD
#define DBG_SSD 0
#endif
DEV void ssd_vectors(const Params& P, const float* SMALL, size_t tok0, int L, int d, int hd, int lane, float& dt0, float& dt1, float& ac0, float& ac1, float& gt, int& i0, int& i1) {
    const float dtb = P.in[I_DTB][L * 32 + d * 16 + hd], A = -__expf(P.in[I_ALOG][L * 32 + d * 16 + hd]);
    const int j0 = 2 * lane, j1 = j0 + 1; i0 = d ? 127 - j0 : j0; i1 = d ? 127 - j1 : j1;
    dt0 = softplusf_(SMALL[(tok0 + i0) * SMW + 16 + d * 16 + hd] + dtb); dt1 = softplusf_(SMALL[(tok0 + i1) * SMW + 16 + d * 16 + hd] + dtb);
    wave_scan2<false>(dt0 * A, dt1 * A, lane, ac0, ac1, gt);
}
DEV void ssd_state_unit(const Params& P, const Ctx& C0, int L, int unit) {
    const Ctx C = fresh(C0);
    const int half = unit & 1, g = (unit >> 1) & 1, ch = (unit >> 2) & 63, b = unit >> 8, tid = C.tid, lane = C.lane, wave = C.wave, fr = lane & 15, fq = lane >> 4;
    const size_t tok0 = (size_t)b * SEQ + ch * 128;
    const bf16* ZINb = (const bf16*)(C.ws + WS_ZIN) + (size_t)b * SEQ * ZW; const float* SMALL = (const float*)(C.ws + WS_SMALL); float* misc = (float*)(C.ws + WS_MISC);
    const float* cw = P.in[I_CONVW] + (size_t)L * 5 * 1536; const float* cb = P.in[I_CONVB] + L * 1536;
    LAS unsigned char* BMs = C.lds; LAS unsigned char* XS = C.lds + 128 * ST128; LAS float* WG = (LAS float*)(C.lds + 128 * ST128 + 128 * ST256);
    const int hl = wave & 3, d = wave >> 2, hd = 8 * g + 4 * half + hl;
    {   float dt0, dt1, a0, a1, gt; int i0, i1; ssd_vectors(P, SMALL, tok0, L, d, hd, lane, dt0, dt1, a0, a1, gt, i0, i1);
        WG[wave * 128 + i0] = dt0 * __expf(gt - a0); WG[wave * 128 + i1] = dt1 * __expf(gt - a1);
        if (lane == 0) misc[OFF_SDEC / 4 + ((b * 2 + d) * 64 + ch) * 16 + hd] = __expf(gt); }
    stage_conv<128>(BMs, ST128, ZINb, ch * 128, ZC_XBC + 1024 + 128 * g, 1024 + 128 * g, cw, cb, tid);
    stage_conv<256>(XS, ST256, ZINb, ch * 128, ZC_XBC + 512 * g + 256 * half, 512 * g + 256 * half, cw, cb, tid);
    __syncthreads();
    bf16* SST = (bf16*)(C.ws + WS_SST) + (size_t)(((b * 2 + d) * 64 + ch) * 16 + hd) * 8192;
    for (int nh = 0; nh < 2; ++nh) {
        f32x4 acc[4][4];
#pragma unroll
        for (int a = 0; a < 4; ++a)
#pragma unroll
            for (int c = 0; c < 4; ++c) acc[a][c] = (f32x4){0.f, 0.f, 0.f, 0.f};
#pragma unroll
        for (int ks = 0; ks < 4; ++ks) {
            const f32x4 w0 = *(const LAS f32x4*)(WG + wave * 128 + 32 * ks + 8 * fq), w1 = *(const LAS f32x4*)(WG + wave * 128 + 32 * ks + 8 * fq + 4);
            bf16x8 bx[4];
#pragma unroll
            for (int pt = 0; pt < 4; ++pt) bx[pt] = frag_scale8(frag_tr(XS, ST256, 32 * ks, hl * 64 + 16 * pt, lane), w0, w1);
#pragma unroll
            for (int nt = 0; nt < 4; ++nt) { const bf16x8 a = frag_tr(BMs, ST128, 32 * ks, 64 * nh + 16 * nt, lane);
#pragma unroll
                for (int pt = 0; pt < 4; ++pt) acc[nt][pt] = mfma16(a, bx[pt], acc[nt][pt]); } }
#pragma unroll
        for (int nt = 0; nt < 4; ++nt)
#pragma unroll
            for (int pt = 0; pt < 4; ++pt) { u32x2 w; w.x = pk2(acc[nt][pt][0], acc[nt][pt][1]); w.y = pk2(acc[nt][pt][2], acc[nt][pt][3]);
                *(GAS u32x2*)(SST + (size_t)(16 * pt + fr) * 128 + 64 * nh + 16 * nt + 4 * fq) = w; }
    }
    __syncthreads();
}
DEV void ssd_scan(const Ctx& C0) {
    const Ctx C = fresh(C0);
    const float* SDEC = (const float*)(C.ws + WS_MISC) + OFF_SDEC / 4; bf16* SST = (bf16*)(C.ws + WS_SST);
    const int nthreads = C.G * 512;
    for (int t = C.bid * 512 + C.tid; t < 64 * 2048; t += nthreads) {
        const int e4 = t & 2047, hd = (t >> 11) & 15, bd = t >> 15, d = bd & 1;
        bf16* base = SST + (size_t)(bd * 64 * 16 + hd) * 8192 + e4 * 4; const size_t cst = (size_t)16 * 8192;
        f32x4 st = (f32x4){0.f, 0.f, 0.f, 0.f};
#pragma unroll 1
        for (int s8 = 0; s8 < 64; s8 += 32) { u32x2 x[32];
#pragma unroll
            for (int k = 0; k < 32; ++k) { const int ch = d ? 63 - (s8 + k) : s8 + k; x[k] = *(const GAS u32x2*)(base + (size_t)ch * cst); }
#pragma unroll
            for (int k = 0; k < 32; ++k) { const int ch = d ? 63 - (s8 + k) : s8 + k; const float dc = SDEC[(bd * 64 + ch) * 16 + hd];
                u32x2 w; w.x = pk2(st[0], st[1]); w.y = pk2(st[2], st[3]); *(GAS u32x2*)(base + (size_t)ch * cst) = w;
                st = st * dc + (f32x4){bflo(x[k].x), bfhi(x[k].x), bflo(x[k].y), bfhi(x[k].y)}; } }
    }
}
DEV void ssd_out_unit(const Params& P, const Ctx& C0, int L, int unit) {
    const Ctx C = fresh(C0);
    const int half = unit & 1, g = (unit >> 1) & 1, ch = (unit >> 2) & 63, b = unit >> 8, tid = C.tid, lane = C.lane, wave = C.wave, fr = lane & 15, fq = lane >> 4;
    const size_t tok0 = (size_t)b * SEQ + ch * 128;
    const bf16* ZIN = (const bf16*)(C.ws + WS_ZIN); const bf16* ZINb = ZIN + (size_t)b * SEQ * ZW; const float* SMALL = (const float*)(C.ws + WS_SMALL);
    const float* cw = P.in[I_CONVW] + (size_t)L * 5 * 1536; const float* cb = P.in[I_CONVB] + L * 1536;
    LAS unsigned char* CMs = C.lds; LAS unsigned char* BC = C.lds + 128 * ST128; LAS unsigned char* XS = C.lds + 2 * 128 * ST128;
    LAS float* DT = (LAS float*)(C.lds + 2 * 128 * ST128 + 128 * ST256); LAS float* ACS = DT + 8 * 128;
    {   const int hl = wave & 3, d = wave >> 2, hd = 8 * g + 4 * half + hl;
        float dt0, dt1, a0, a1, gt; int i0, i1; ssd_vectors(P, SMALL, tok0, L, d, hd, lane, dt0, dt1, a0, a1, gt, i0, i1);
        DT[wave * 128 + i0] = dt0; DT[wave * 128 + i1] = dt1; ACS[wave * 128 + i0] = a0; ACS[wave * 128 + i1] = a1; }
    stage_conv<128>(CMs, ST128, ZINb, ch * 128, ZC_XBC + 1280 + 128 * g, 1280 + 128 * g, cw, cb, tid);
    stage_conv<128>(BC, ST128, ZINb, ch * 128, ZC_XBC + 1024 + 128 * g, 1024 + 128 * g, cw, cb, tid);
    stage_conv<256>(XS, ST256, ZINb, ch * 128, ZC_XBC + 512 * g + 256 * half, 512 * g + 256 * half, cw, cb, tid);
    __syncthreads();
    {
        f32x4 cbr[8];
#pragma unroll
        for (int st = 0; st < 8; ++st) cbr[st] = (f32x4){0.f, 0.f, 0.f, 0.f};
#pragma unroll
        for (int ks = 0; ks < 4; ++ks) { const bf16x8 bc = frag_row(CMs, ST128, 16 * wave, 32 * ks, lane);
#pragma unroll
            for (int st = 0; st < 8; ++st) cbr[st] = mfma16(frag_row(BC, ST128, 16 * st, 32 * ks, lane), bc, cbr[st]); }
        __syncthreads();
        const int t = 16 * wave + fr;
#pragma unroll
        for (int st = 0; st < 8; ++st) { u32x2 w; w.x = pk2(cbr[st][0], cbr[st][1]); w.y = pk2(cbr[st][2], cbr[st][3]); *(LAS u32x2*)(BC + t * ST128 + (16 * st + 4 * fq) * 2) = w; }
    }
    __syncthreads();
    const int hl = wave & 3, th = wave >> 2, hd = 8 * g + 4 * half + hl;
    f32x4 acc[4][4];
#pragma unroll
    for (int a = 0; a < 4; ++a)
#pragma unroll
        for (int c = 0; c < 4; ++c) acc[a][c] = (f32x4){0.f, 0.f, 0.f, 0.f};
    for (int d = 0; d < 2; ++d) {
        const LAS float* dtv = DT + (hl + 4 * d) * 128; const LAS float* acv = ACS + (hl + 4 * d) * 128;
        const bf16* S0 = (const bf16*)(C.ws + WS_SST) + (size_t)(((b * 2 + d) * 64 + ch) * 16 + hd) * 8192;
        bf16x8 bs[4][4];
#pragma unroll
        for (int ks = 0; ks < 4; ++ks)
#pragma unroll
            for (int pt = 0; pt < 4; ++pt) bs[ks][pt] = *(const GAS bf16x8*)(S0 + (size_t)(16 * pt + fr) * 128 + 32 * ks + 8 * fq);
#pragma unroll 1
        for (int ks = 0; ks < 4; ++ks) {
            bf16x8 bx[4];
#pragma unroll
            for (int pt = 0; pt < 4; ++pt) bx[pt] = frag_tr(XS, ST256, 32 * ks, hl * 64 + 16 * pt, lane);
            const int s0 = 32 * ks + 8 * fq;
            const f32x4 as0 = *(const LAS f32x4*)(acv + s0), as1 = *(const LAS f32x4*)(acv + s0 + 4), ds0 = *(const LAS f32x4*)(dtv + s0), ds1 = *(const LAS f32x4*)(dtv + s0 + 4);
#pragma unroll
            for (int tt = 0; tt < 4; ++tt) { const int t = 64 * th + 16 * tt + fr; const float at = acv[t];
                const bf16x8 cbf = frag_row(BC, ST128, 64 * th + 16 * tt, 32 * ks, lane); f32x4 l0, l1;
#pragma unroll
                for (int e = 0; e < 4; ++e) { const int sa = s0 + e, sb = s0 + 4 + e; const bool va = d ? (sa >= t) : (sa <= t), vb = d ? (sb >= t) : (sb <= t);
                    l0[e] = va ? __expf(at - as0[e]) * ds0[e] : 0.f; l1[e] = vb ? __expf(at - as1[e]) * ds1[e] : 0.f; }
                const bf16x8 a = frag_scale8(cbf, l0, l1);
#pragma unroll
                for (int pt = 0; pt < 4; ++pt) if (!((DBG_SSD >> 0) & 1) && !((DBG_SSD >> (2 + d)) & 1)) acc[tt][pt] = mfma16(a, bx[pt], acc[tt][pt]); } }
#pragma unroll
        for (int ks = 0; ks < 4; ++ks) {
#pragma unroll
            for (int tt = 0; tt < 4; ++tt) { const int t = 64 * th + 16 * tt + fr;
                const bf16x8 a = frag_scale(frag_row(CMs, ST128, 64 * th + 16 * tt, 32 * ks, lane), __expf(acv[t]));
#pragma unroll
                for (int pt = 0; pt < 4; ++pt) if (!((DBG_SSD >> 1) & 1) && !((DBG_SSD >> (2 + d)) & 1)) acc[tt][pt] = mfma16(a, bs[ks][pt], acc[tt][pt]);
                __builtin_amdgcn_sched_barrier(0); } }
    }
    __syncthreads();
    LAS unsigned char* YT = C.lds;
#pragma unroll
    for (int tt = 0; tt < 4; ++tt)
#pragma unroll
        for (int i = 0; i < 4; ++i) { const int t = 64 * th + 16 * tt + 4 * fq + i;
#pragma unroll
            for (int pt = 0; pt < 4; ++pt) *(LAS unsigned short*)(YT + t * ST256 + (hl * 64 + 16 * pt + fr) * 2) = (unsigned short)f2bf(acc[tt][pt][i]); }
    __syncthreads();
    {   bf16* YB = (bf16*)(C.ws + WS_Y) + (size_t)M * 1024; u64* ybss = (u64*)(C.ws + OFF_YBSS) + (size_t)L * M; const int ch0 = 512 * g + 256 * half;
        u32x4 zq[8];
#pragma unroll
        for (int k = 0; k < 8; ++k) { const int c = tid + 512 * k, t = c >> 5, c8 = (c & 31) * 8; zq[k] = *(const GAS u32x4*)(ZIN + (tok0 + t) * ZW + ZC_BZ + ch0 + c8); }
#pragma unroll
        for (int k = 0; k < 8; ++k) { const int c = tid + 512 * k, t = c >> 5, c8 = (c & 31) * 8; float yv[8], xv[8], zv[8], o[8];
            const float dsk = P.in[I_SSD][L * 16 + 8 * g + 4 * half + (c8 >> 6)];
            unpack8(*(const LAS u32x4*)(YT + t * ST256 + c8 * 2), yv); unpack8(*(const LAS u32x4*)(XS + t * ST256 + c8 * 2), xv); unpack8(zq[k], zv);
            float part = 0.f;
#pragma unroll
            for (int e = 0; e < 8; ++e) { o[e] = (yv[e] + dsk * xv[e]) * siluf_(zv[e]); part += o[e] * o[e]; }
            *(GAS u32x4*)(YB + (tok0 + t) * 1024 + ch0 + c8) = pack8(o);
            part += shx(part, 1, lane); part += shx(part, 2, lane); part += shx(part, 4, lane); part += shx(part, 8, lane); part += shx(part, 16, lane);
            if ((lane & 31) == 0) ss_add(ybss + tok0 + t, part); }
    }
    __syncthreads();
}

DEV void krope_phase(const Ctx& C0) {
    const Ctx C = fresh(C0);
    const float* SMALL = (const float*)(C.ws + WS_SMALL); const float* COS = (const float*)(C.ws + WS_COS); const float* SIN = (const float*)(C.ws + WS_SIN); bf16* KR = (bf16*)(C.ws + WS_KR);
    for (int i = C.bid * 512 + C.tid; i < M * 32; i += C.G * 512) { const int m = i >> 5, j = i & 31;
        const float t1 = SMALL[(size_t)m * SMW + 48 + j], t2 = SMALL[(size_t)m * SMW + 80 + j], cs = COS[i], sn = SIN[i];
        KR[(size_t)m * 64 + j] = (bf16)f2bf(t1 * cs - t2 * sn); KR[(size_t)m * 64 + 32 + j] = (bf16)f2bf(t2 * cs + t1 * sn); }
}
DEV void final_phase(const Params& P, const Ctx& C0) {
    const Ctx C = fresh(C0);
    const bf16* HB = (const bf16*)(C.ws + WS_HB0); const u64* hss = (const u64*)(C.ws + OFF_HSS) + (size_t)16 * M; const float* gn = P.in[I_FIN];
    for (size_t i = (size_t)C.bid * 512 + C.tid; i < (size_t)M * DM / 8; i += (size_t)C.G * 512) { const int m = (int)(i >> 8), c = (int)(i & 255) * 8;
        const float rs = ss_to_rstd(hss[m], 1.f / DM); float h[8]; unpack8(*(const GAS u32x4*)(HB + i * 8), h);
        const f32x4 g0 = *(const f32x4*)(gn + c), g1 = *(const f32x4*)(gn + c + 4);
        *(GAS f32x4*)(P.out + i * 8) = (f32x4){h[0] * rs * g0[0], h[1] * rs * g0[1], h[2] * rs * g0[2], h[3] * rs * g0[3]};
        *(GAS f32x4*)(P.out + i * 8 + 4) = (f32x4){h[4] * rs * g1[0], h[5] * rs * g1[1], h[6] * rs * g1[2], h[7] * rs * g1[3]}; }
}
#ifndef MK_MODE
#define MK_MODE 0
#endif
constexpr int NPHASE = 12;

__global__ void __launch_bounds__(512, 2) mk_fwd(Params P) {
    extern __shared__ __attribute__((aligned(16))) unsigned char lds[];
    Ctx CK; CK.lds = (LAS unsigned char*)lds; CK.ws = P.ws; CK.tid = threadIdx.x; CK.lane = CK.tid & 63; CK.wave = __builtin_amdgcn_readfirstlane(CK.tid >> 6); CK.G = gridDim.x; CK.bid = blockIdx.x;
    volatile LAS unsigned* MISC = (volatile LAS unsigned*)(CK.lds + LDS_MISC);
    if (CK.tid < 64) MISC[CK.tid] = 0u;
    __syncthreads();
    XcdBarrier bar; bar.bar = (unsigned*)(P.ws + WS_CTL) + CW_BAR; bar.x = 0; bar.st = nullptr;
    if (P.use_bar) bar = xcd_barrier_post((unsigned*)(P.ws + WS_CTL) + CW_BAR, MISC + 8);
#define SEAM() do { if (P.use_bar) xcd_barrier(bar); } while (0)
#ifndef MK_DUP
#define MK_DUP 0
#endif
#define REP(k) for (int rep_ = 0; rep_ < (((MK_DUP >> (k)) & 1) ? 2 : 1); ++rep_)
#ifndef MK_SUB
#define MK_SUB 0xFFFF
#endif
#define SUB(k) ((MK_SUB >> (k)) & 1)
#ifndef MK_MASK
#define MK_MASK 0xFFFF
#endif
#define IN(k) (((MK_MASK >> (k)) & 1) && P.ph_lo <= (k) && (k) < P.ph_hi)
#define WSP(T, off) ((T*)(C.ws + (off)))
#define WB WSP(bf16, WS_W)
#define H WSP(float, WS_H)
#define HB0 WSP(bf16, WS_HB0)
#define HB1 WSP(bf16, WS_HB1)
#define ZIN WSP(bf16, WS_ZIN)
#define U WSP(bf16, WS_U)
#define SMALL WSP(float, WS_SMALL)
#define Q WSP(bf16, WS_Q)
#define KN WSP(bf16, WS_KN)
#define V WSP(bf16, WS_V)
#define KR WSP(bf16, WS_KR)
#define PP WSP(bf16, WS_PP)
#define PB WSP(bf16, WS_PB)
#define COS WSP(float, WS_COS)
#define SIN WSP(float, WS_SIN)
#define MERGE WSP(float, WS_MERGE)
#define MERGEB WSP(bf16, WS_MERGEB)
#define Y WSP(bf16, WS_Y)
#define HSS WSP(u64, OFF_HSS)
#define CQSS WSP(u64, OFF_CQSS)
#define CKVSS WSP(u64, OFF_CKVSS)
#define YBSS WSP(u64, OFF_YBSS)
    if (P.l_lo == 0 && P.l_hi > 0 && IN(0)) rope_tables(P, CK);
    for (int L = P.l_lo; L < P.l_hi; ++L) {
        if (IN(0)) REP(0) { const Ctx C = fresh(CK); phase_convert(P, C, L); SEAM(); }
        if (IN(1)) REP(1) { const Ctx C = fresh(CK);
            pg8::Gemm g{HB0, WB + WE_13A, DM, DM, DM}; pg8::StaticOrder S; S.init(M, 2 * FF, C.G, C.bid);
            EpiSwiGLU E{HSS + (size_t)(4 * L) * M, U};
            pg8::gemm_phase<EpiSwiGLU, pg8::StaticOrder, true>(C.lds, g, S, E, C.tid); SEAM(); }
        if (IN(2)) { const Ctx C = fresh(CK);
            pg8::Gemm g{U, WB + WE_2A, FF, FF, FF}; pg8::StaticOrder S; S.init(M, DM, C.G, C.bid);
            EpiResid<0> E{HB0, HB1, HSS + (size_t)(4 * L + 1) * M, 0.5f, nullptr, nullptr};
            pg8::gemm_phase<EpiResid<0>, pg8::StaticOrder, true>(C.lds, g, S, E, C.tid); SEAM(); }
        if (IN(3)) { const Ctx C = fresh(CK);
            pg8::Gemm g{HB1, WB + WE_IN, DM, DM, DM}; pg8::StaticOrder S; S.init(M, WIN_ROWS, C.G, C.bid);
            EpiWin E{HSS + (size_t)(4 * L + 1) * M, ZIN, SMALL, CQSS + (size_t)L * M, CKVSS + (size_t)L * M};
            pg8::gemm_phase<EpiWin, pg8::StaticOrder, true>(C.lds, g, S, E, C.tid); SEAM(); }
        if (IN(4)) REP(4) { const Ctx C = fresh(CK);
            if (SUB(2)) { pg8::Gemm g{ZIN + ZC_CQ, WB + WE_UQ, ZW, 512, 512}; pg8::StaticOrder S; S.init(M, 1536, C.G, C.bid);
              EpiQup E{CQSS + (size_t)L * M, Q, COS, SIN}; pg8::gemm_phase<EpiQup, pg8::StaticOrder, true>(C.lds, g, S, E, C.tid); }
            if (SUB(3)) { pg8::Gemm g{ZIN + ZC_CKV, WB + WE_UKV, ZW, 512, 512}; pg8::StaticOrder S; S.init(M, 2048, C.G, C.bid);
              EpiKVup E{CKVSS + (size_t)L * M, KN, V}; pg8::gemm_phase<EpiKVup, pg8::StaticOrder, true>(C.lds, g, S, E, C.tid); }
            krope_phase(C);
            if (SUB(0)) for (int u = C.bid; u < 512; u += C.G) mlstm_state_unit(P, C, L, u);
            if (SUB(1)) for (int u = C.bid; u < 512; u += C.G) ssd_state_unit(P, C, L, u);
            SEAM(); }
        if (IN(5)) { const Ctx C = fresh(CK);
            if (SUB(7)) { mlstm_scan(C); ssd_scan(C); }
            if (SUB(6)) REP(13) for (int i = 0; i < 512; i += C.G) { int bh, qb;
                if (C.G == 256) { bh = (C.bid & 7) + 8 * (i >> 8); qb = C.bid >> 3; } else { const int u = i + C.bid; if (u >= 512) break; bh = u >> 5; qb = u & 31; }
                const int b = bh >> 3, h = bh & 7;
                att::attn_unit(Q + ((size_t)bh * SEQ + qb * 256) * 192, KN + (size_t)bh * SEQ * 128, V + (size_t)bh * SEQ * 128, KR + (size_t)b * SEQ * 64,
                               Y + (size_t)2 * M * 1024 + ((size_t)b * SEQ + qb * 256) * 1024 + h * 128, SEQ, (char*)lds, CK.lds, fresh(CK).tid); }
            SEAM(); }
        if (IN(6)) { const Ctx C = fresh(CK);
            if (SUB(4)) REP(14) for (int u = C.bid; u < 512; u += C.G) mlstm_out_unit(P, C, L, u);
            if (SUB(5)) for (int u = C.bid; u < 512; u += C.G) ssd_out_unit(P, C, L, u);
            SEAM(); }
        if (IN(7)) REP(7) { const Ctx C = fresh(CK);
            if (SUB(8)) { pg8::Gemm g{Y, WB + WE_BR, 1024, 1024, 1024}; pg8::BranchOrder S{C.G, C.bid};
              EpiBranch E{ZIN, YBSS + (size_t)L * M, MERGEB}; pg8::gemm_phase<EpiBranch, pg8::BranchOrder, true>(C.lds, g, S, E, C.tid); }
            if (SUB(9)) { pg8::Gemm g{PB, WB + WE_PP, PLE, PLE, PLE}; pg8::StaticOrder S; S.init(M, DM, C.G, C.bid);
              EpiPlain E{PP, DM}; pg8::gemm_phase<EpiPlain, pg8::StaticOrder, true>(C.lds, g, S, E, C.tid); }
            SEAM(); }
        if (IN(8)) { const Ctx C = fresh(CK);
            pg8::Gemm g{MERGEB, WB + WE_OUT, DM, DM, DM}; pg8::StaticOrder S; S.init(M, DM, C.G, C.bid);
            EpiResid<0> E{HB1, HB0, HSS + (size_t)(4 * L + 2) * M, 1.0f, nullptr, nullptr};
            pg8::gemm_phase<EpiResid<0>, pg8::StaticOrder, true>(C.lds, g, S, E, C.tid); SEAM(); }
        if (IN(9)) { const Ctx C = fresh(CK);
            pg8::Gemm g{HB0, WB + WE_13B, DM, DM, DM}; pg8::StaticOrder S; S.init(M, 2 * FF, C.G, C.bid);
            EpiSwiGLU E{HSS + (size_t)(4 * L + 2) * M, U};
            pg8::gemm_phase<EpiSwiGLU, pg8::StaticOrder, true>(C.lds, g, S, E, C.tid); SEAM(); }
        if (IN(10)) { const Ctx C = fresh(CK);
            pg8::Gemm g{U, WB + WE_2B, FF, FF, FF}; pg8::StaticOrder S; S.init(M, DM, C.G, C.bid);
            EpiResid<0> E{HB0, HB1, HSS + (size_t)(4 * L + 3) * M, 0.5f, nullptr, nullptr};
            pg8::gemm_phase<EpiResid<0>, pg8::StaticOrder, true>(C.lds, g, S, E, C.tid); SEAM(); }
        if (IN(11)) { const Ctx C = fresh(CK);
            pg8::Gemm g{HB1, WB + WE_PG, DM, DM, DM}; pg8::StaticOrder S; S.init(M, DM, C.G, C.bid);
            EpiResid<1> E{HB1, HB0, HSS + (size_t)(4 * L + 4) * M, 0.f, HSS + (size_t)(4 * L + 3) * M, PP};
            pg8::gemm_phase<EpiResid<1>, pg8::StaticOrder, true>(C.lds, g, S, E, C.tid); SEAM(); }
    }
    if (((MK_MASK >> 12) & 1) && P.l_hi == DEPTH && P.ph_hi > NPHASE) final_phase(P, CK);
#undef SEAM
#undef IN
#undef WSP
#undef WB
#undef H
#undef HB0
#undef HB1
#undef ZIN
#undef U
#undef SMALL
#undef Q
#undef KN
#undef V
#undef KR
#undef PP
#undef PB
#undef COS
#undef SIN
#undef MERGE
#undef MERGEB
#undef Y
#undef HSS
#undef CQSS
#undef CKVSS
#undef YBSS
}

extern "C" void kernel_launch(void* const* d_in, const int* in_sizes, int n_in, void* d_out, int out_size, void* d_ws, size_t ws_size, hipStream_t stream) {
    static int grid = 0;
    if (grid == 0) {
        if (n_in != 30 || in_sizes[0] != M * DM || out_size != M * DM || ws_size < WS_END) {
            fprintf(stderr, "kernel_launch: unexpected shapes: n_in %d in0 %d out %d ws %zu (need %zu)\n", n_in, n_in > 0 ? in_sizes[0] : -1, out_size, ws_size, (size_t)WS_END); grid = -1; return; }
        int dev = 0, cus = 0, per_cu = 0;
        if (hipGetDevice(&dev) != hipSuccess || hipDeviceGetAttribute(&cus, hipDeviceAttributeMultiprocessorCount, dev) != hipSuccess) { grid = -1; return; }
        if (hipFuncSetAttribute((const void*)mk_fwd, hipFuncAttributeMaxDynamicSharedMemorySize, LDS_BYTES) != hipSuccess) { fprintf(stderr, "kernel_launch: hipFuncSetAttribute failed\n"); grid = -1; return; }
        if (hipOccupancyMaxActiveBlocksPerMultiprocessor(&per_cu, (const void*)mk_fwd, 512, LDS_BYTES) != hipSuccess || per_cu < 1)
            fprintf(stderr, "kernel_launch: note: occupancy query reports %d workgroups per CU\n", per_cu);
        (void)hipGetLastError();
        grid = cus;
    }
    if (grid < 0) return;
    if (hipMemsetAsync((char*)d_ws + WS_CTL, 0, CTL_ZERO_BYTES, stream) != hipSuccess) return;
    Params p; memset(&p, 0, sizeof(p));
    for (int i = 0; i < 30; ++i) p.in[i] = (const float*)d_in[i];
    p.out = (float*)d_out; p.ws = (unsigned char*)d_ws;
#if MK_MODE == 0
    p.l_lo = 0; p.l_hi = DEPTH; p.ph_lo = 0; p.ph_hi = NPHASE + 1; p.use_bar = 1;
    hipLaunchKernelGGL(mk_fwd, dim3(grid), dim3(512), LDS_BYTES, stream, p);
#else
    p.use_bar = 0;
    for (int L = 0; L < DEPTH; ++L)
        for (int k = 0; k < NPHASE; ++k) { p.l_lo = L; p.l_hi = L + 1; p.ph_lo = k; p.ph_hi = k + 1;
            hipLaunchKernelGGL(mk_fwd, dim3(grid), dim3(512), LDS_BYTES, stream, p); }
    p.l_lo = DEPTH; p.l_hi = DEPTH; p.ph_lo = NPHASE; p.ph_hi = NPHASE + 1;
    hipLaunchKernelGGL(mk_fwd, dim3(grid), dim3(512), LDS_BYTES, stream, p);
#endif
    const hipError_t le = hipPeekAtLastError();
    if (le != hipSuccess) fprintf(stderr, "kernel_launch: launch failed: %s\n", hipGetErrorName(le));
}
```

```cpp
#include <hip/hip_runtime.h>
#include <cstdio>
#include <cstdint>
#include <cstring>

#define DEV __device__ __forceinline__
#define LAS __attribute__((address_space(3)))
#define GAS __attribute__((address_space(1)))
typedef unsigned short bf16;
typedef unsigned long long u64;
typedef short bf16x8 __attribute__((ext_vector_type(8)));
typedef short s16x4 __attribute__((ext_vector_type(4)));
typedef float f32x4 __attribute__((ext_vector_type(4)));
typedef float f32x16 __attribute__((ext_vector_type(16)));
typedef unsigned u32x4 __attribute__((ext_vector_type(4)));
typedef unsigned u32x2 __attribute__((ext_vector_type(2)));

namespace pg8 {
#define PG8_LAS __attribute__((address_space(3)))
typedef unsigned short bf16_t;
constexpr int BM = 256, BK = 64, HALF = 128, HTB = HALF * BK * 2, STAGE_BYTES = 8 * HTB, NXCD = 8, WGM = 4;

__host__ __device__ __forceinline__ int lds_byte(int r, int c) { const int st = (r >> 4) * 2 + (c >> 5), rr = r & 15, cc = c & 31, ob = rr * 64 + cc * 2; return st * 1024 + (ob ^ (((ob >> 9) & 1) << 5)); }
__host__ __device__ __forceinline__ void stage_rc(int b, int& R, int& C) { const int st = b / 1024, sb = b % 1024, swz = sb ^ (((sb >> 9) & 1) << 5); R = (st >> 1) * 16 + swz / 64; C = (st & 1) * 32 + (swz % 64) / 2; }
__host__ __device__ __forceinline__ int perm32(int rho) { const int n = rho >> 4, i = rho & 15; return 8 * (i >> 2) + 4 * n + (i & 3); }

struct Unit { int pm, pn; };
struct Gemm { const bf16_t* A; const bf16_t* Bt; int lda, ldb, K; };

struct StaticOrder {
    int nM, nN, nwg, G, c;
    __host__ __device__ void init(int M, int N, int G_, int c_) { nM = M / BM; nN = N / BM; nwg = nM * nN; G = G_; c = c_; }
    __host__ __device__ bool next(int i, Unit& u) const {
        const long L = (long)i * G + c; if (L >= nwg) return false;
        int wgid = (int)L; { const int q = nwg / NXCD, r = nwg % NXCD, xcd = wgid % NXCD, off = wgid / NXCD; wgid = (xcd < r ? xcd * (q + 1) : r * (q + 1) + (xcd - r) * q) + off; }
        const int nig = WGM * nN, gid = wgid / nig, fm = gid * WGM, gsz = (nM - fm) < WGM ? (nM - fm) : WGM;
        u.pm = fm + ((wgid % nig) % gsz); u.pn = (wgid % nig) / gsz; return true;
    }
};
struct BranchOrder {
    int G, c;
    __host__ __device__ bool next(int i, Unit& u) const {
        StaticOrder S; S.init(16384, 2048, G, c); Unit t; if (!S.next(i / 3, t)) return false;
        const int j = i % 3; u.pm = j * 64 + t.pm; u.pn = j * 8 + t.pn; return true;
    }
};

constexpr int PRE_OFF = STAGE_BYTES;
template <class Epi, class Sched, bool ALIGN_EPI>
__device__ __forceinline__ void gemm_phase(PG8_LAS unsigned char* lds, const Gemm g, const Sched& S, const Epi& E, int tid_in) {
    int tid_ = tid_in; asm volatile("" : "+v"(tid_));
    const int tid = tid_, wid = __builtin_amdgcn_readfirstlane(tid >> 6), lane = tid & 63, wr = wid >> 2, wc = wid & 3, fr = lane & 15, fq = lane >> 4;
    const int K = g.K, nt = K / BK;
    unsigned voffA[2], voffB[2];
#pragma unroll
    for (int i = 0; i < 2; ++i) { int R, C; stage_rc(tid * 16 + i * 8192, R, C); const int Rb = (R & ~31) + perm32(R & 31);
        voffA[i] = (unsigned)(R * g.lda + C) * 2u; voffB[i] = (unsigned)(Rb * g.ldb + C) * 2u; }
    const size_t kstep = (size_t)(BK * 2);
    const size_t hstepA = (size_t)HALF * g.lda * 2, hstepB = (size_t)HALF * g.ldb * 2;
    const size_t tstepA = 2 * hstepA, tstepB = 2 * hstepB;
    const unsigned ldsw = (unsigned)wid * 1024u;
    const int aoff = lds_byte(wr * 64 + fr, fq * 8), boff = lds_byte(wc * 32 + fr, fq * 8);
#define PG8_SA(b, h) (((b) * 2 + (h)) * HTB)
#define PG8_SB(b, h) ((4 + (b) * 2 + (h)) * HTB)
#define PG8_STAGE(bufoff, gbase, voff) do { _Pragma("unroll") for (int _i = 0; _i < 2; ++_i) \
        __builtin_amdgcn_global_load_lds((const unsigned*)((const char*)(gbase) + (voff)[_i]), (PG8_LAS unsigned*)(lds + (bufoff) + ldsw + _i * 8192), 16, 0, 0); } while (0)
#define PG8_LDA(dst, b, h) do { _Pragma("unroll") for (int m = 0; m < 4; ++m) _Pragma("unroll") for (int k = 0; k < 2; ++k) dst[m][k] = *(const PG8_LAS bf16x8*)(lds + PG8_SA(b, h) + aoff + m * 2048 + k * 1024); } while (0)
#define PG8_LDB(dst, b, h) do { _Pragma("unroll") for (int n = 0; n < 2; ++n) _Pragma("unroll") for (int k = 0; k < 2; ++k) dst[n][k] = *(const PG8_LAS bf16x8*)(lds + PG8_SB(b, h) + boff + n * 2048 + k * 1024); } while (0)
#define PG8_MMA(ai, bj, At, Bt) do { __builtin_amdgcn_s_setprio(1); _Pragma("unroll") for (int m = 0; m < 4; ++m) _Pragma("unroll") for (int n = 0; n < 2; ++n) _Pragma("unroll") for (int k = 0; k < 2; ++k) \
        acc[ai][bj][m][n] = __builtin_amdgcn_mfma_f32_16x16x32_bf16(Bt[n][k], At[m][k], acc[ai][bj][m][n], 0, 0, 0); __builtin_amdgcn_s_setprio(0); } while (0)
#define PG8_WAIT_V(n) asm volatile("s_waitcnt vmcnt(" #n ")" ::: "memory")
#define PG8_WAIT_L(n) asm volatile("s_waitcnt lgkmcnt(" #n ")" ::: "memory")
#define PG8_BAR __builtin_amdgcn_s_barrier()
#define PG8_SCHED __builtin_amdgcn_sched_barrier(0)
    Unit cur, nxt; int ui = 0;
    if (!S.next(0, cur)) return;
    PG8_LAS unsigned long long* const pre = (PG8_LAS unsigned long long*)(lds + PRE_OFF + wid * 1024);
#define PG8_PRE(u) do { if constexpr (Epi::PRE) { int ln_ = lane; asm volatile("" : "+v"(ln_));     \
        const int prerow = wr * 64 + ((ln_ >> 5) & 1) * 128 + ((ln_ >> 3) & 3) * 16 + 2 * (ln_ & 7); \
        __builtin_amdgcn_global_load_lds((const unsigned*)(E.pre_ptr() + (u).pm * 256 + prerow), (PG8_LAS unsigned*)pre, 16, 0, 0); } } while (0)
    PG8_PRE(cur);
    f32x4 acc[2][2][4][2];
#pragma unroll
    for (int a = 0; a < 2; ++a)
#pragma unroll
        for (int b = 0; b < 2; ++b)
#pragma unroll
            for (int m = 0; m < 4; ++m)
#pragma unroll
                for (int n = 0; n < 2; ++n) acc[a][b][m][n] = (f32x4){0.f, 0.f, 0.f, 0.f};
    bf16x8 At[4][2], B0[2][2], B1[2][2];
    const char* cA = (const char*)g.A + (size_t)cur.pm * tstepA; const char* cB = (const char*)g.Bt + (size_t)cur.pn * tstepB;
    PG8_STAGE(PG8_SB(0, 0), cB, voffB); PG8_STAGE(PG8_SB(0, 1), cB + hstepB, voffB); PG8_STAGE(PG8_SA(0, 0), cA, voffA); PG8_STAGE(PG8_SA(0, 1), cA + hstepA, voffA);
    if (wr == 1) PG8_BAR;
    PG8_WAIT_V(2); PG8_BAR;
    PG8_STAGE(PG8_SB(1, 0), cB + kstep, voffB); PG8_STAGE(PG8_SA(1, 0), cA + kstep, voffA); PG8_STAGE(PG8_SB(1, 1), cB + hstepB + kstep, voffB);
    PG8_WAIT_V(6); PG8_BAR;
    for (;;) {
        const bool has_next = S.next(ui + 1, nxt);
        const char* nA = has_next ? (const char*)g.A + (size_t)nxt.pm * tstepA : cA; const char* nB = has_next ? (const char*)g.Bt + (size_t)nxt.pn * tstepB : cB;
#pragma unroll 1
        for (int t = 0; t < nt; t += 2) {
            const bool last = (t == nt - 2);
            const char* a1 = cA + (size_t)(t + 1) * kstep;
            const char* a2 = last ? nA : cA + (size_t)(t + 2) * kstep; const char* b2 = last ? nB : cB + (size_t)(t + 2) * kstep;
            const char* a3 = a2 + kstep; const char* b3 = b2 + kstep;
            PG8_LDB(B0, 0, 0); PG8_LDB(B1, 0, 1); PG8_SCHED; PG8_LDA(At, 0, 0); PG8_STAGE(PG8_SA(1, 1), a1 + hstepA, voffA);
            PG8_WAIT_V(8); PG8_WAIT_L(0); PG8_BAR; PG8_MMA(0, 0, At, B0); PG8_MMA(0, 1, At, B1); PG8_BAR; PG8_SCHED;
            PG8_LDA(At, 0, 1); PG8_STAGE(PG8_SB(0, 0), b2, voffB); PG8_STAGE(PG8_SB(0, 1), b2 + hstepB, voffB); PG8_STAGE(PG8_SA(0, 0), a2, voffA);
            PG8_WAIT_V(8); PG8_WAIT_L(0); PG8_BAR; PG8_MMA(1, 0, At, B0); PG8_MMA(1, 1, At, B1); PG8_BAR; PG8_SCHED;
            PG8_LDB(B0, 1, 0); PG8_LDB(B1, 1, 1); PG8_SCHED; PG8_LDA(At, 1, 0); PG8_STAGE(PG8_SA(0, 1), a2 + hstepA, voffA);
            PG8_WAIT_V(8); PG8_WAIT_L(0); PG8_BAR; PG8_MMA(0, 0, At, B0); PG8_MMA(0, 1, At, B1); PG8_BAR; PG8_SCHED;
            PG8_LDA(At, 1, 1); PG8_STAGE(PG8_SB(1, 0), b3, voffB); PG8_STAGE(PG8_SB(1, 1), b3 + hstepB, voffB); PG8_STAGE(PG8_SA(1, 0), a3, voffA);
            PG8_WAIT_V(8); PG8_WAIT_L(0); PG8_BAR; PG8_MMA(1, 0, At, B0); PG8_MMA(1, 1, At, B1); PG8_BAR; PG8_SCHED;
        }
        if constexpr (ALIGN_EPI) { if (wr == 0) PG8_BAR; }
        E(acc, cur, wr, wc, fr, fq, pre);
        if (!has_next) break;
        if constexpr (Epi::PRE) { PG8_WAIT_L(0); PG8_PRE(nxt); }
#pragma unroll
        for (int a = 0; a < 2; ++a)
#pragma unroll
            for (int b = 0; b < 2; ++b)
#pragma unroll
                for (int m = 0; m < 4; ++m)
#pragma unroll
                    for (int n = 0; n < 2; ++n) acc[a][b][m][n] = (f32x4){0.f, 0.f, 0.f, 0.f};
        cur = nxt; cA = nA; cB = nB; ++ui;
        if constexpr (ALIGN_EPI) { if (wr == 1) PG8_BAR; }
    }
    PG8_WAIT_V(0);
    if constexpr (!ALIGN_EPI) { if (wr == 0) PG8_BAR; }
    PG8_BAR;
#undef PG8_PRE
#undef PG8_SA
#undef PG8_SB
#undef PG8_STAGE
#undef PG8_LDA
#undef PG8_LDB
#undef PG8_MMA
#undef PG8_WAIT_V
#undef PG8_WAIT_L
#undef PG8_BAR
#undef PG8_SCHED
}
}

#define XB_TMO      128
#define XB_XCNT(j)  (256  + 64 * (j))
#define XB_XSUB(j)  (1280 + 64 * (j))
#define XB_XGEN(j)  (2304 + 64 * (j))
#define XB_TOP      3328
#define XB_TOPGEN   3392
#define XCD_BAR_WORDS 3456
#define XB_SPIN_CAP (1u << 18)

__device__ __forceinline__ unsigned xb_ld(unsigned* p)              { return __hip_atomic_load(p, __ATOMIC_RELAXED, __HIP_MEMORY_SCOPE_AGENT); }
__device__ __forceinline__ unsigned xb_add(unsigned* p, unsigned v) { return __hip_atomic_fetch_add(p, v, __ATOMIC_RELAXED, __HIP_MEMORY_SCOPE_AGENT); }
__device__ __forceinline__ unsigned xb_xcc_id() { return (unsigned)__builtin_amdgcn_s_getreg((3 << 11) | 20) & 0xFu; }
#define XB_SPIN(cond, bar) do { unsigned _sp = 0; while (cond) { __builtin_amdgcn_s_sleep(1); \
    if ((++_sp & 255u) == 0u) { if (xb_ld(&(bar)[XB_TMO])) break; if (_sp > XB_SPIN_CAP) { atomicAdd(&(bar)[XB_TMO], 1u); break; } } } } while (0)

struct XcdBarrier { unsigned* bar; unsigned x; volatile LAS unsigned* st; };

__device__ __forceinline__ XcdBarrier xcd_barrier_post(unsigned* bar, volatile LAS unsigned* st) {
    XcdBarrier b; b.bar = bar; b.x = xb_xcc_id(); b.st = st;
    if (threadIdx.x == 0) (void)xb_add(&bar[XB_XCNT(b.x)], 1u);
    return b;
}
__device__ __forceinline__ void xcd_barrier_complete(unsigned* bar, unsigned x, unsigned& nloc, unsigned& nx) {
    const unsigned G = gridDim.x * gridDim.y * gridDim.z;
    unsigned sum, cnt, mine, sp = 0u;
    for (;;) {
        sum = 0u; cnt = 0u; mine = 0u;
#pragma unroll
        for (unsigned j = 0; j < 16; ++j) { const unsigned c = xb_ld(&bar[XB_XCNT(j)]); sum += c; cnt += (c > 0u) ? 1u : 0u; mine = (j == x) ? c : mine; }
        if (sum == G) break;
        __builtin_amdgcn_s_sleep(1);
        if ((++sp & 255u) == 0u) { if (xb_ld(&bar[XB_TMO])) break; if (sp > XB_SPIN_CAP) { atomicAdd(&bar[XB_TMO], 1u); break; } }
    }
    nloc = mine > 0u ? mine : 1u; nx = cnt > 0u ? cnt : 1u;
}
__device__ __forceinline__ void xcd_barrier(const XcdBarrier& b) {
    asm volatile("s_waitcnt vmcnt(0)" ::: "memory");
    __syncthreads();
    if (threadIdx.x == 0) {
        unsigned* bar = b.bar;
        __builtin_amdgcn_s_waitcnt(0);
        unsigned nloc = b.st[0], nx = b.st[1];
        if (nloc == 0u) { xcd_barrier_complete(bar, b.x, nloc, nx); b.st[0] = nloc; b.st[1] = nx; }
        const unsigned old = xb_add(&bar[XB_XSUB(b.x)], 1u);
        const unsigned gen = old / nloc;
        if (old + 1u == (gen + 1u) * nloc) {
            __builtin_amdgcn_fence(__ATOMIC_RELEASE, "agent");
            asm volatile("s_waitcnt vmcnt(0)" ::: "memory");
            const unsigned og = xb_add(&bar[XB_TOP], 1u);
            const unsigned tg = og / nx;
            if (og + 1u == (tg + 1u) * nx) xb_add(&bar[XB_TOPGEN], 1u);
            else XB_SPIN(xb_ld(&bar[XB_TOPGEN]) == tg, bar);
            __builtin_amdgcn_fence(__ATOMIC_ACQUIRE, "agent");
            xb_add(&bar[XB_XGEN(b.x)], 1u);
            asm volatile("s_waitcnt vmcnt(0)" ::: "memory");
        } else {
            XB_SPIN(xb_ld(&bar[XB_XGEN(b.x)]) == gen, bar);
            __builtin_amdgcn_fence(__ATOMIC_ACQUIRE, "agent");
            asm volatile("s_waitcnt vmcnt(0)" ::: "memory");
        }
    }
    __syncthreads();
}
constexpr int NB = 2, SEQ = 8192, M = NB * SEQ, DM = 2048, FF = 5632, DEPTH = 4, PLE = 256;
constexpr int DIN_SRC = 12912, ZW = 12800, WIN_ROWS = 13056;
constexpr int ZC_AQ = 0, ZC_AK = 512, ZC_AV = 1024, ZC_AO = 2048, ZC_BZ = 3072, ZC_XBC = 4096, ZC_CQ = 5632, ZC_CKV = 6144, ZC_GATE = 6656;
constexpr int SMW = 128;
constexpr float EPS = 1e-6f;
constexpr size_t MiB = 1u << 20;
constexpr size_t WS_CTL = 0, CTL_ZERO_BYTES = 8 * MiB;
constexpr int CW_BAR = 4096;
constexpr size_t OFF_HSS = 1 * MiB;
constexpr size_t OFF_CQSS = OFF_HSS + (size_t)17 * M * 8;
constexpr size_t OFF_CKVSS = OFF_CQSS + (size_t)4 * M * 8;
constexpr size_t OFF_YBSS = OFF_CKVSS + (size_t)4 * M * 8;
static_assert(OFF_YBSS + (size_t)4 * M * 8 <= CTL_ZERO_BYTES, "ctl");
constexpr size_t WS_W = 8 * MiB;
constexpr size_t WE_13A = 0, WE_2A = WE_13A + (size_t)2 * FF * DM, WE_IN = WE_2A + (size_t)DM * FF, WE_UQ = WE_IN + (size_t)WIN_ROWS * DM,
                 WE_UKV = WE_UQ + (size_t)1536 * 512, WE_BR = WE_UKV + (size_t)2048 * 512, WE_OUT = WE_BR + (size_t)3 * DM * 1024,
                 WE_13B = WE_OUT + (size_t)DM * DM, WE_2B = WE_13B + (size_t)2 * FF * DM, WE_PG = WE_2B + (size_t)DM * FF, WE_PP = WE_PG + (size_t)DM * DM,
                 WE_END = WE_PP + (size_t)DM * PLE;
static_assert(WE_END * 2 <= 216 * MiB, "weights");
constexpr size_t WS_H = 224 * MiB;
constexpr size_t WS_HB0 = 352 * MiB, WS_HB1 = 416 * MiB;
constexpr size_t WS_ZIN = 480 * MiB;
constexpr size_t WS_U = WS_ZIN;
constexpr size_t WS_SMALL = 880 * MiB;
constexpr size_t WS_Q = 888 * MiB;
constexpr size_t WS_KN = 936 * MiB;
constexpr size_t WS_V = 968 * MiB;
constexpr size_t WS_PP = WS_Q;
constexpr size_t WS_KR = 1000 * MiB;
constexpr size_t WS_COS = 1002 * MiB, WS_SIN = 1004 * MiB;
constexpr size_t WS_PB = 1006 * MiB;
constexpr size_t WS_MISC = 1014 * MiB;
constexpr size_t OFF_MLOC = 0, OFF_MG = 4096, OFF_M0 = 8192, OFF_NLOC = 16384  , OFF_SDEC = OFF_NLOC + 1024 * 128 * 4  ;
constexpr size_t WS_CLOC = 1016 * MiB;
constexpr size_t WS_MERGE = WS_CLOC;
constexpr size_t WS_SST = 1144 * MiB;
constexpr size_t WS_MERGEB = WS_SST;
constexpr size_t WS_Y = 1272 * MiB;
constexpr size_t WS_END = 1368 * MiB;

constexpr int LDS_BYTES = 155648;
constexpr int LDS_MISC = 153600;
constexpr int NWAVES = 8;

typedef float f32x2_t __attribute__((ext_vector_type(2))); typedef __bf16 bf16x2_t __attribute__((ext_vector_type(2)));
DEV unsigned f2bf(float f) { return (unsigned)__builtin_bit_cast(unsigned short, (__bf16)f); }
DEV unsigned pk2(float lo, float hi) { f32x2_t v = {lo, hi}; bf16x2_t b = __builtin_convertvector(v, bf16x2_t); return __builtin_bit_cast(unsigned, b); }
DEV float bf2f(unsigned short b) { return __builtin_bit_cast(float, (unsigned)b << 16); }
DEV float bflo(unsigned w) { return __builtin_bit_cast(float, w << 16); }
DEV float bfhi(unsigned w) { return __builtin_bit_cast(float, w & 0xffff0000u); }
DEV float sigmoidf_(float x) { return __builtin_amdgcn_rcpf(1.f + __expf(-x)); }
DEV float siluf_(float x) { return x * __builtin_amdgcn_rcpf(1.f + __expf(-x)); }
DEV float softplusf_(float x) { return fmaxf(x, 0.f) + log1pf(__expf(-fabsf(x))); }
DEV float logsigf_(float x) { return fminf(x, 0.f) - log1pf(__expf(-fabsf(x))); }
DEV float ss_to_rstd(u64 s, float inv_n) { return rsqrtf((float)s * (1.f / 4294967296.f) * inv_n + EPS); }
DEV void ss_add(u64* p, float part) { atomicAdd((unsigned long long*)p, (unsigned long long)(part * 4294967296.f)); }
DEV float shx(float v, int m, int lane) { return __uint_as_float((unsigned)__builtin_amdgcn_ds_bpermute((lane ^ m) << 2, (int)__float_as_uint(v))); }
DEV float shup(float v, int d, int lane) { const int src = lane >= d ? lane - d : lane; return __uint_as_float((unsigned)__builtin_amdgcn_ds_bpermute(src << 2, (int)__float_as_uint(v))); }
DEV float xsum16(float v) { auto r = __builtin_amdgcn_permlane16_swap(__float_as_uint(v), __float_as_uint(v), false, false); return __uint_as_float(r[0]) + __uint_as_float(r[1]); }
DEV float xsum32(float v) { auto r = __builtin_amdgcn_permlane32_swap(__float_as_uint(v), __float_as_uint(v), false, false); return __uint_as_float(r[0]) + __uint_as_float(r[1]); }
DEV float wave_sum(float v, int lane) {
#pragma unroll
    for (int o = 1; o < 16; o <<= 1) v += shx(v, o, lane);
    return xsum32(xsum16(v));
}
DEV float wave_max(float v, int lane) {
#pragma unroll
    for (int o = 1; o < 64; o <<= 1) v = fmaxf(v, shx(v, o, lane));
    return v;
}
DEV u32x4 pack8(const float* v) { u32x4 w; w.x = pk2(v[0], v[1]); w.y = pk2(v[2], v[3]); w.z = pk2(v[4], v[5]); w.w = pk2(v[6], v[7]); return w; }
DEV void unpack8(u32x4 w, float* v) { v[0] = bflo(w.x); v[1] = bfhi(w.x); v[2] = bflo(w.y); v[3] = bfhi(w.y); v[4] = bflo(w.z); v[5] = bfhi(w.z); v[6] = bflo(w.w); v[7] = bfhi(w.w); }

typedef f32x4 Acc[2][2][4][2];
#define EPI_ROWS(...) _Pragma("unroll") for (int ai = 0; ai < 2; ++ai) _Pragma("unroll") for (int m = 0; m < 4; ++m) { const int rg = ai * 4 + m; const int row = row0 + ai * 128 + m * 16; __VA_ARGS__ }
DEV void load_rstd8(float (&rs)[8], const u64* ss, int row0, float inv_n) {
    u64 t[8];
#pragma unroll
    for (int rg = 0; rg < 8; ++rg) t[rg] = *(const GAS u64*)(ss + row0 + (rg >> 2) * 128 + (rg & 3) * 16);
#pragma unroll
    for (int rg = 0; rg < 8; ++rg) rs[rg] = ss_to_rstd(t[rg], inv_n);
}
typedef const LAS u64* PrePtr;
DEV void lds_rstd8(float (&rs)[8], PrePtr pre, int fr, float inv_n) {
    u64 t[8];
#pragma unroll
    for (int rg = 0; rg < 8; ++rg) t[rg] = pre[rg * 16 + fr];
#pragma unroll
    for (int rg = 0; rg < 8; ++rg) rs[rg] = ss_to_rstd(t[rg], inv_n);
}
struct EpiSwiGLU {
    static constexpr bool PRE = true; const u64* ss; bf16* U; DEV const u64* pre_ptr() const { return ss; }
    DEV void operator()(const Acc& acc, const pg8::Unit& u, int wr, int wc, int fr, int fq, PrePtr pre) const {
        const int row0 = u.pm * 256 + wr * 64 + fr, col0 = u.pn * 128 + wc * 32 + 8 * fq;
        float rs[8]; lds_rstd8(rs, pre, fr, 1.f / DM);
        EPI_ROWS( float o[8];
            const float k1 = -1.4426950408889634f * rs[rg], r2 = rs[rg] * rs[rg];
            _Pragma("unroll") for (int n = 0; n < 2; ++n) _Pragma("unroll") for (int i = 0; i < 4; ++i) { const float a = acc[ai][0][m][n][i], b = acc[ai][1][m][n][i];
                const float q = __builtin_amdgcn_rcpf(1.f + __builtin_amdgcn_exp2f(a * k1)); o[n * 4 + i] = (a * b) * (r2 * q); }
            *(GAS u32x4*)(U + (size_t)row * FF + col0) = pack8(o); )
    }
};
template <int MODE> struct EpiResid {
    static constexpr bool PRE = false; const bf16* HBi; bf16* HBo; u64* sso; float alpha; const u64* ssi; const bf16* PP;
    DEV void operator()(const Acc& acc, const pg8::Unit& u, int wr, int wc, int fr, int fq, PrePtr pre) const {
        const int row0 = u.pm * 256 + wr * 64 + fr, col0 = u.pn * 256 + wc * 32 + 8 * fq;
        float rs[8]; if (MODE == 1) load_rstd8(rs, ssi, row0, 1.f / DM);
        constexpr int MB = (MODE == 1) ? 2 : 4;
#pragma unroll
        for (int bt = 0; bt < 8 / MB; ++bt) {
            u32x4 hb[MB][2], pq[MB][2];
#pragma unroll
            for (int mm = 0; mm < MB; ++mm)
#pragma unroll
                for (int bj = 0; bj < 2; ++bj) { const int rg = bt * MB + mm; const size_t off = (size_t)(row0 + (rg >> 2) * 128 + (rg & 3) * 16) * DM + col0 + bj * 128;
                    hb[mm][bj] = *(const GAS u32x4*)(HBi + off); if (MODE == 1) pq[mm][bj] = *(const GAS u32x4*)(PP + off); }
            __builtin_amdgcn_sched_barrier(0);
#pragma unroll
            for (int mm = 0; mm < MB; ++mm) { const int rg = bt * MB + mm, ai = rg >> 2, m = rg & 3; const int row = row0 + ai * 128 + m * 16; float part = 0.f;
#pragma unroll
                for (int bj = 0; bj < 2; ++bj) { float hv[8], pv[8], o[8]; unpack8(hb[mm][bj], hv); if (MODE == 1) unpack8(pq[mm][bj], pv);
#pragma unroll
                    for (int n = 0; n < 2; ++n)
#pragma unroll
                        for (int i = 0; i < 4; ++i) { const int e = n * 4 + i;
                            o[e] = (MODE == 0) ? hv[e] + alpha * acc[ai][bj][m][n][i] : hv[e] + sigmoidf_(acc[ai][bj][m][n][i] * rs[rg]) * pv[e]; part += o[e] * o[e]; }
                    *(GAS u32x4*)(HBo + (size_t)row * DM + col0 + bj * 128) = pack8(o); }
                part = xsum32(xsum16(part));
                if (fq == 0) ss_add(sso + row, part); }
        }
    }
};
struct EpiWin {
    static constexpr bool PRE = true; DEV const u64* pre_ptr() const { return ssi; } const u64* ssi; bf16* ZIN; float* SMALL; u64* cqss; u64* ckvss;
    template <bool GATE> DEV void body(const Acc& acc, const pg8::Unit& u, int row0, int cw, int fq, const float (&rs)[8]) const {
        const int pn = u.pn; const bool stat = (pn >= 22 && pn < 26);
        EPI_ROWS( float part = 0.f;
            _Pragma("unroll") for (int bj = 0; bj < 2; ++bj) { float o[8];
                _Pragma("unroll") for (int n = 0; n < 2; ++n) _Pragma("unroll") for (int i = 0; i < 4; ++i) { float v = acc[ai][bj][m][n][i] * rs[rg]; if (!GATE) part += v * v; o[n * 4 + i] = GATE ? sigmoidf_(v) : v; }
                if (GATE || pn < 50) *(GAS u32x4*)(ZIN + (size_t)row * ZW + pn * 256 + bj * 128 + cw) = pack8(o);
                else if (bj == 0) { GAS float* d = (GAS float*)(SMALL + (size_t)row * SMW + cw); *(GAS f32x4*)d = (f32x4){o[0], o[1], o[2], o[3]}; *(GAS f32x4*)(d + 4) = (f32x4){o[4], o[5], o[6], o[7]}; } }
            if (!GATE && stat) { part = xsum32(xsum16(part)); if (fq == 0) ss_add((pn < 24 ? cqss : ckvss) + row, part); } )
    }
    DEV void operator()(const Acc& acc, const pg8::Unit& u, int wr, int wc, int fr, int fq, PrePtr pre) const {
        const int row0 = u.pm * 256 + wr * 64 + fr, cw = wc * 32 + 8 * fq;
        float rs[8]; lds_rstd8(rs, pre, fr, 1.f / DM);
        if (u.pn >= 26 && u.pn < 50) body<true>(acc, u, row0, cw, fq, rs);
        else body<false>(acc, u, row0, cw, fq, rs);
    }
};
struct EpiQup {
    static constexpr bool PRE = true; DEV const u64* pre_ptr() const { return ss; } const u64* ss; bf16* Q; const float* COS; const float* SIN;
    DEV void operator()(const Acc& acc, const pg8::Unit& u, int wr, int wc, int fr, int fq, PrePtr pre) const {
        const int row0 = u.pm * 256 + wr * 64 + fr, pn = u.pn;
        float rs[8]; lds_rstd8(rs, pre, fr, 1.f / 512.f);
        EPI_ROWS( const int b = row >> 13, s = row & (SEQ - 1);
            if (pn < 4) {
                _Pragma("unroll") for (int bj = 0; bj < 2; ++bj) { const int head = 2 * pn + bj; float o[8];
                    _Pragma("unroll") for (int n = 0; n < 2; ++n) _Pragma("unroll") for (int i = 0; i < 4; ++i) o[n * 4 + i] = acc[ai][bj][m][n][i] * rs[rg];
                    *(GAS u32x4*)(Q + ((size_t)(b * 8 + head) * SEQ + s) * 192 + wc * 32 + 8 * fq) = pack8(o); }
            } else { const int head = 4 * (pn - 4) + wc, j0 = 8 * fq; float o1[8], o2[8];
                const f32x4 c0 = *(const GAS f32x4*)(COS + (size_t)row * 32 + j0), c1 = *(const GAS f32x4*)(COS + (size_t)row * 32 + j0 + 4);
                const f32x4 s0 = *(const GAS f32x4*)(SIN + (size_t)row * 32 + j0), s1 = *(const GAS f32x4*)(SIN + (size_t)row * 32 + j0 + 4);
                _Pragma("unroll") for (int n = 0; n < 2; ++n) _Pragma("unroll") for (int i = 0; i < 4; ++i) { const float x1 = acc[ai][0][m][n][i] * rs[rg], x2 = acc[ai][1][m][n][i] * rs[rg]; const float cs = n ? c1[i] : c0[i], sn = n ? s1[i] : s0[i];
                    o1[n * 4 + i] = x1 * cs - x2 * sn; o2[n * 4 + i] = x2 * cs + x1 * sn; }
                bf16* qp = Q + ((size_t)(b * 8 + head) * SEQ + s) * 192 + 128 + j0;
                *(GAS u32x4*)qp = pack8(o1); *(GAS u32x4*)(qp + 32) = pack8(o2); } )
    }
};
struct EpiKVup {
    static constexpr bool PRE = true; DEV const u64* pre_ptr() const { return ss; } const u64* ss; bf16* KN; bf16* V;
    DEV void operator()(const Acc& acc, const pg8::Unit& u, int wr, int wc, int fr, int fq, PrePtr pre) const {
        const int row0 = u.pm * 256 + wr * 64 + fr, head = u.pn;
        float rs[8]; lds_rstd8(rs, pre, fr, 1.f / 512.f);
        EPI_ROWS( const int b = row >> 13, s = row & (SEQ - 1); const size_t off = ((size_t)(b * 8 + head) * SEQ + s) * 128 + wc * 32 + 8 * fq;
            _Pragma("unroll") for (int bj = 0; bj < 2; ++bj) { float o[8];
                _Pragma("unroll") for (int n = 0; n < 2; ++n) _Pragma("unroll") for (int i = 0; i < 4; ++i) o[n * 4 + i] = acc[ai][bj][m][n][i] * rs[rg];
                *(GAS u32x4*)((bj ? V : KN) + off) = pack8(o); } )
    }
};
struct EpiPlain {
    static constexpr bool PRE = false; bf16* O; int ldc;
    DEV void operator()(const Acc& acc, const pg8::Unit& u, int wr, int wc, int fr, int fq, PrePtr pre) const {
        const int row0 = u.pm * 256 + wr * 64 + fr, col0 = u.pn * 256 + wc * 32 + 8 * fq;
        EPI_ROWS( (void)rg;
            _Pragma("unroll") for (int bj = 0; bj < 2; ++bj) { float o[8];
                _Pragma("unroll") for (int n = 0; n < 2; ++n) _Pragma("unroll") for (int i = 0; i < 4; ++i) o[n * 4 + i] = acc[ai][bj][m][n][i];
                *(GAS u32x4*)(O + (size_t)row * ldc + col0 + bj * 128) = pack8(o); } )
    }
};
#ifndef DBG_DBL
#define DBG_DBL 0
#endif
#ifndef DBG_ZERO
#define DBG_ZERO 0
#endif
struct EpiBranch {
    static constexpr bool PRE = false; const bf16* ZIN; const u64* ybss; bf16* MERGEB;
    DEV void operator()(const Acc& acc, const pg8::Unit& u, int wr, int wc, int fr, int fq, PrePtr pre) const {
        const int j = u.pm >> 6, pm = u.pm & 63, pn = u.pn & 7;
        const int row0 = pm * 256 + wr * 64 + fr, col0 = pn * 256 + wc * 32 + 8 * fq;
        float rs[8];
        if (j == 1) load_rstd8(rs, ybss, row0, 1.f / 1024.f);
        else {
#pragma unroll
            for (int rg = 0; rg < 8; ++rg) rs[rg] = 1.f; }
        u32x4 gq[2][2], mq[2][2];
#define BR_LOAD(slot, rgx) _Pragma("unroll") for (int bj = 0; bj < 2; ++bj) { const int row = row0 + ((rgx) >> 2) * 128 + ((rgx) & 3) * 16, col = col0 + bj * 128; \
            gq[slot][bj] = *(const GAS u32x4*)(ZIN + (size_t)row * ZW + ZC_GATE + j * DM + col); \
            mq[slot][bj] = (u32x4){0u, 0u, 0u, 0u}; if (j > 0) mq[slot][bj] = *(const GAS u32x4*)(MERGEB + (size_t)row * DM + col); }
        BR_LOAD(0, 0)
#pragma unroll
        for (int rg = 0; rg < 8; ++rg) {
            if (rg + 1 < 8) { if ((rg & 1) == 0) { BR_LOAD(1, rg + 1) } else { BR_LOAD(0, rg + 1) } }
            __builtin_amdgcn_sched_barrier(0);
#pragma unroll
            for (int bj = 0; bj < 2; ++bj) { const int ai = rg >> 2, m = rg & 3; const int row = row0 + ai * 128 + m * 16, col = col0 + bj * 128; float g[8], p[8], o[8]; unpack8(gq[rg & 1][bj], g); unpack8(mq[rg & 1][bj], p);
#pragma unroll
                for (int n = 0; n < 2; ++n)
#pragma unroll
                    for (int i = 0; i < 4; ++i) o[n * 4 + i] = p[n * 4 + i] + (((DBG_ZERO >> j) & 1) ? 0.f : acc[ai][bj][m][n][i] * rs[rg] * g[n * 4 + i] * (((DBG_DBL >> j) & 1) ? 2.f : 1.f));
                *(GAS u32x4*)(MERGEB + (size_t)row * DM + col) = pack8(o); }
        }
#undef BR_LOAD
    }
};
#undef EPI_ROWS
struct Params {
    const float* in[30];
    float* out; unsigned char* ws;
    int l_lo, l_hi, ph_lo, ph_hi;
    int use_bar, pad;
};
enum { I_X = 0, I_P, I_POS, I_F1N, I_F1W13, I_F1W2, I_MIXN, I_WIN, I_BIG, I_BFG, I_MLN, I_CONVW, I_CONVB, I_ALOG, I_DTB, I_SSD, I_SSN,
       I_QN, I_KVN, I_WUQ, I_WUKV, I_WBR, I_WOUT, I_F2N, I_F2W13, I_F2W2, I_PLN, I_WPG, I_WPP, I_FIN };

struct Ctx {
    LAS unsigned char* lds; unsigned char* ws; int tid, lane, wave, G, bid;
};
DEV Ctx fresh(const Ctx& C0) { Ctx C = C0;
    int wv = C0.wave; unsigned char* w = C0.ws; int g = C0.G, b = C0.bid; asm volatile("" : "+s"(wv), "+s"(w), "+s"(g), "+s"(b));
    int ln = (int)__builtin_amdgcn_mbcnt_hi(~0u, __builtin_amdgcn_mbcnt_lo(~0u, 0u)); asm volatile("" : "+v"(ln));
    C.wave = wv; C.lane = ln; C.tid = wv * 64 + ln; C.ws = w; C.G = g; C.bid = b; return C; }

__constant__ double INVF[32] = {1.0, 0.7498942093324559, 0.5623413251903491, 0.4216965034285822, 0.31622776601683794, 0.23713737056616552, 0.1778279410038923, 0.1333521432163324, 0.1, 0.07498942093324558, 0.05623413251903491, 0.042169650342858224, 0.03162277660168379, 0.023713737056616554, 0.01778279410038923, 0.01333521432163324, 0.01, 0.007498942093324558, 0.005623413251903491, 0.004216965034285823, 0.0031622776601683794, 0.0023713737056616554, 0.0017782794100389228, 0.001333521432163324, 0.001, 0.0007498942093324559, 0.0005623413251903491, 0.00042169650342858224, 0.00031622776601683794, 0.00023713737056616554, 0.00017782794100389227, 0.0001333521432163324};
struct MapId  { DEV int operator()(int r) const { return r; } };
struct MapW13 { DEV int operator()(int r) const { const int t = r >> 8, w = r & 255; return (w >= 128 ? FF : 0) + 128 * t + (w & 127); } };
struct MapWin { DEV int operator()(int r) const {
    if (r < 3072) return r; if (r < 5632) return r + 16; if (r < 6656) return r + 48; if (r < 12800) return r + 112;
    r -= 12800; if (r < 16) return 3072 + r; if (r < 48) return 5648 + (r - 16); if (r < 112) return 6704 + (r - 48); return -1; } };
struct MapUq  { DEV int operator()(int r) const {
    if (r < 1024) return (r >> 7) * 192 + (r & 127);
    const int rr = r - 1024, tile = rr >> 8, w = rr & 255, t2 = w >> 7, hl = (w & 127) >> 5, j = w & 31; return (4 * tile + hl) * 192 + 128 + 32 * t2 + j; } };

struct CvtItem { const float* W; const float* gain; bf16* WT; int ldw, K, sc, kk0, row; };
DEV int cvt_map(int id, int r) { return id == 0 ? MapId()(r) : id == 1 ? MapW13()(r) : id == 2 ? MapWin()(r) : MapUq()(r); }
DEV CvtItem cvt_describe(const Params& P, unsigned char* ws, int L, int it, int lane) {
    constexpr int N13 = (2 * FF / 64) * (DM / 64), N2 = (DM / 64) * (FF / 64), NIN = (WIN_ROWS / 64) * (DM / 64), NUQ = (1536 / 64) * (512 / 64), NUKV = (2048 / 64) * (512 / 64),
                  NBR = (DM / 64) * (1024 / 64), NSQ = (DM / 64) * (DM / 64);
    bf16* WB = (bf16*)(ws + WS_W); CvtItem d; int r = it, mapid = 0;
    if (r < N13) { d.W = P.in[I_F1W13] + (size_t)L * DM * 2 * FF; d.ldw = 2 * FF; d.K = DM; d.gain = P.in[I_F1N] + L * DM; d.WT = WB + WE_13A; mapid = 1; }
    else if ((r -= N13) < N13) { d.W = P.in[I_F2W13] + (size_t)L * DM * 2 * FF; d.ldw = 2 * FF; d.K = DM; d.gain = P.in[I_F2N] + L * DM; d.WT = WB + WE_13B; mapid = 1; }
    else if ((r -= N13) < N2) { d.W = P.in[I_F1W2] + (size_t)L * FF * DM; d.ldw = DM; d.K = FF; d.gain = nullptr; d.WT = WB + WE_2A; }
    else if ((r -= N2) < N2) { d.W = P.in[I_F2W2] + (size_t)L * FF * DM; d.ldw = DM; d.K = FF; d.gain = nullptr; d.WT = WB + WE_2B; }
    else if ((r -= N2) < NIN) { d.W = P.in[I_WIN] + (size_t)L * DM * DIN_SRC; d.ldw = DIN_SRC; d.K = DM; d.gain = P.in[I_MIXN] + L * DM; d.WT = WB + WE_IN; mapid = 2; }
    else if ((r -= NIN) < NUQ) { d.W = P.in[I_WUQ] + (size_t)L * 512 * 1536; d.ldw = 1536; d.K = 512; d.gain = P.in[I_QN] + L * 512; d.WT = WB + WE_UQ; mapid = 3; }
    else if ((r -= NUQ) < NUKV) { d.W = P.in[I_WUKV] + (size_t)L * 512 * 2048; d.ldw = 2048; d.K = 512; d.gain = P.in[I_KVN] + L * 512; d.WT = WB + WE_UKV; }
    else if ((r -= NUKV) < 3 * NBR) { const int j = r / NBR; r -= j * NBR; d.W = P.in[I_WBR] + (size_t)L * 3 * 1024 * DM + (size_t)j * 1024 * DM; d.ldw = DM; d.K = 1024; d.gain = (j == 1) ? P.in[I_SSN] + L * 1024 : nullptr; d.WT = WB + WE_BR + (size_t)j * DM * 1024; }
    else if ((r -= 3 * NBR) < NSQ) { d.W = P.in[I_WOUT] + (size_t)L * DM * DM; d.ldw = DM; d.K = DM; d.gain = nullptr; d.WT = WB + WE_OUT; }
    else if ((r -= NSQ) < NSQ) { d.W = P.in[I_WPG] + (size_t)L * DM * DM; d.ldw = DM; d.K = DM; d.gain = P.in[I_PLN] + L * DM; d.WT = WB + WE_PG; }
    else { r -= NSQ; d.W = P.in[I_WPP] + (size_t)L * PLE * DM; d.ldw = DM; d.K = PLE; d.gain = nullptr; d.WT = WB + WE_PP; }
    const int nkb = d.K / 64, rb = r / nkb, kb = r - rb * nkb; d.row = 64 * rb + (lane & 15) * 4; d.kk0 = 64 * kb + 16 * (lane >> 4); d.sc = cvt_map(mapid, d.row);
    return d;
}
DEV void cvt_load(const CvtItem& d, f32x4 (&v)[16]) {
#pragma unroll
    for (int i = 0; i < 16; ++i) { v[i] = (f32x4){0.f, 0.f, 0.f, 0.f}; if (d.sc >= 0) v[i] = *(const GAS f32x4*)(d.W + (size_t)(d.kk0 + i) * d.ldw + d.sc); }
}
DEV void cvt_store(const CvtItem& d, const f32x4 (&v)[16]) {
    f32x4 g[4];
#pragma unroll
    for (int q = 0; q < 4; ++q) g[q] = d.gain ? *(const GAS f32x4*)(d.gain + d.kk0 + 4 * q) : (f32x4){1.f, 1.f, 1.f, 1.f};
#pragma unroll
    for (int jn = 0; jn < 4; ++jn) { u32x4 o0, o1;
        o0.x = pk2(v[0][jn] * g[0][0], v[1][jn] * g[0][1]); o0.y = pk2(v[2][jn] * g[0][2], v[3][jn] * g[0][3]); o0.z = pk2(v[4][jn] * g[1][0], v[5][jn] * g[1][1]); o0.w = pk2(v[6][jn] * g[1][2], v[7][jn] * g[1][3]);
        o1.x = pk2(v[8][jn] * g[2][0], v[9][jn] * g[2][1]); o1.y = pk2(v[10][jn] * g[2][2], v[11][jn] * g[2][3]); o1.z = pk2(v[12][jn] * g[3][0], v[13][jn] * g[3][1]); o1.w = pk2(v[14][jn] * g[3][2], v[15][jn] * g[3][3]);
        bf16* p = d.WT + (size_t)(d.row + jn) * d.K + d.kk0;
        *(GAS u32x4*)p = o0; *(GAS u32x4*)(p + 8) = o1; }
}

DEV void phase_convert(const Params& P, const Ctx& C0, int L) {
    const Ctx C = fresh(C0);
    const int gw = C.bid * NWAVES + C.wave, NGW = C.G * NWAVES, lane = C.lane;
    constexpr int NITEMS = 2 * (2 * FF / 64) * (DM / 64) + 2 * (DM / 64) * (FF / 64) + (WIN_ROWS / 64) * (DM / 64) + (1536 / 64) * (512 / 64) + (2048 / 64) * (512 / 64)
                         + 3 * (DM / 64) * (1024 / 64) + 2 * (DM / 64) * (DM / 64) + (DM / 64) * (PLE / 64);
    if (gw < NITEMS) {
        f32x4 va[16], vb[16]; CvtItem da = cvt_describe(P, C.ws, L, gw, lane), db = da; cvt_load(da, va);
        for (int it = gw;;) {
            const int itb = it + NGW; const bool hb = itb < NITEMS;
            if (hb) { db = cvt_describe(P, C.ws, L, itb, lane); cvt_load(db, vb); }
            cvt_store(da, va); if (!hb) break;
            const int ita = itb + NGW; const bool ha = ita < NITEMS;
            if (ha) { da = cvt_describe(P, C.ws, L, ita, lane); cvt_load(da, va); }
            cvt_store(db, vb); if (!ha) break;
            it = ita;
        }
    }
    { const float* p = P.in[I_P] + (size_t)L * M * PLE; bf16* PB = (bf16*)(C.ws + WS_PB);
      const int gt = C.bid * 512 + C.tid, NGT = C.G * 512;
      for (int i = gt; i < M * PLE / 8; i += NGT) { const f32x4 a = *(const f32x4*)(p + (size_t)i * 8), b = *(const f32x4*)(p + (size_t)i * 8 + 4);
          u32x4 o; o.x = pk2(a[0], a[1]); o.y = pk2(a[2], a[3]); o.z = pk2(b[0], b[1]); o.w = pk2(b[2], b[3]); *(u32x4*)(PB + (size_t)i * 8) = o; } }
    if (L == 0) {
        const float* x = P.in[I_X]; bf16* HB = (bf16*)(C.ws + WS_HB0); u64* hss = (u64*)(C.ws + OFF_HSS);
        for (int m = gw; m < M; m += NGW) { float s = 0.f;
#pragma unroll
            for (int j = 0; j < 4; ++j) { const size_t off = (size_t)m * DM + j * 512 + lane * 8; const f32x4 a = *(const f32x4*)(x + off), b = *(const f32x4*)(x + off + 4);
                u32x4 o; o.x = pk2(a[0], a[1]); o.y = pk2(a[2], a[3]); o.z = pk2(b[0], b[1]); o.w = pk2(b[2], b[3]); *(u32x4*)(HB + off) = o;
                s += a[0] * a[0] + a[1] * a[1] + a[2] * a[2] + a[3] * a[3] + b[0] * b[0] + b[1] * b[1] + b[2] * b[2] + b[3] * b[3]; }
            s = wave_sum(s, lane); if (lane == 0) hss[m] = (u64)(s * 4294967296.f); }
    }
}

DEV void rope_tables(const Params& P, const Ctx& C0) {
    const Ctx C = fresh(C0);
        const int* pos = (const int*)P.in[I_POS]; float* COS = (float*)(C.ws + WS_COS); float* SIN = (float*)(C.ws + WS_SIN);
        const int gt = C.bid * 512 + C.tid, NGT = C.G * 512;
        for (int i = gt; i < M * 32; i += NGT) { const int m = i >> 5, j = i & 31; const double ang = (double)pos[m] * INVF[j];
            const double n = rint(ang * 0.6366197723675814); double r = fma(-n, 1.5707963267948966, ang); r = fma(-n, 6.123233995736766e-17, r);
            const double r2 = r * r;
            double sn = 1.0 / 6227020800.0; sn = fma(sn, r2, -1.0 / 39916800.0); sn = fma(sn, r2, 1.0 / 362880.0); sn = fma(sn, r2, -1.0 / 5040.0); sn = fma(sn, r2, 1.0 / 120.0); sn = fma(sn, r2, -1.0 / 6.0); sn = fma(sn * r2, r, r);
            double cs = -1.0 / 87178291200.0; cs = fma(cs, r2, 1.0 / 479001600.0); cs = fma(cs, r2, -1.0 / 3628800.0); cs = fma(cs, r2, 1.0 / 40320.0); cs = fma(cs, r2, -1.0 / 720.0); cs = fma(cs, r2, 1.0 / 24.0); cs = fma(cs, r2, -0.5); cs = fma(cs, r2, 1.0);
            const int q = ((int)n) & 3; const double so = (q == 0) ? sn : (q == 1) ? cs : (q == 2) ? -sn : -cs; const double co = (q == 0) ? cs : (q == 1) ? -sn : (q == 2) ? -cs : sn;
            COS[i] = (float)co; SIN[i] = (float)so; }
}
namespace att {
constexpr int NW = 8, QBLK = 32, KVBLK = 64;
constexpr float SCALE = 0.07216878364870323f;
constexpr float THR = 8.f;
constexpr int LDQ = 192, LDK = 128, LDR = 64, LDO = 1024;
constexpr int SHM_V = KVBLK * 128 * 2, SHM_K = KVBLK * 128 * 2, SHM_R = KVBLK * 64 * 2;
constexpr int NBUF = 3;
constexpr int OFF_V = 0, OFF_K = NBUF * SHM_V, OFF_R = OFF_K + NBUF * SHM_K, OFF_WS = OFF_R + NBUF * SHM_R, SHM_ATTN = OFF_WS + NW * 64 * 4;
#define KSWZ(row, colB) ((row) * 256 + ((colB) ^ (((row) & 7) << 4)))
#define RSWZ(row, colB) ((row) * 128 + ((colB) ^ (((row) & 7) << 4)))
#define SBAR() __builtin_amdgcn_sched_barrier(0)
DEV int crow(int r, int hi) { return (r & 3) + 8 * (r >> 2) + 4 * hi; }
DEV unsigned cvtpk(float lo, float hi) { return pk2(lo, hi); }
DEV bf16x8 ld8(const bf16* p) { return *(const GAS bf16x8*)p; }

template <int ST> DEV void partialSM_part(f32x16& p0, f32x16& p1, float& m_reg, float& mn, float& alpha, float& pmax, float& mnC) {
  constexpr float C = SCALE * 1.4426950408889634f;
  if constexpr (ST == 0) {
    pmax = p0[0];
#pragma unroll
    for (int r = 1; r < 16; ++r) pmax = fmaxf(pmax, p0[r]);
#pragma unroll
    for (int r = 0; r < 16; ++r) pmax = fmaxf(pmax, p1[r]);
    { auto rr = __builtin_amdgcn_permlane32_swap(__float_as_uint(pmax), __float_as_uint(pmax), false, false);
      pmax = fmaxf(__uint_as_float(rr[0]), __uint_as_float(rr[1])); }
  } else if constexpr (ST == 1) {
    if (__builtin_expect(__all(pmax - m_reg <= THR / SCALE), 1)) { mn = m_reg; alpha = 1.f; }
    else { mn = fmaxf(m_reg, pmax); alpha = __builtin_amdgcn_exp2f((m_reg - mn) * C); m_reg = mn; }
    mnC = -mn * C;
#pragma unroll
    for (int r = 0; r < 16; ++r) p0[r] = fmaf(p0[r], C, mnC);
#pragma unroll
    for (int r = 0; r < 8; ++r) p1[r] = fmaf(p1[r], C, mnC);
  } else if constexpr (ST == 2) {
#pragma unroll
    for (int r = 8; r < 16; ++r) p1[r] = fmaf(p1[r], C, mnC);
#pragma unroll
    for (int r = 0; r < 6; ++r) p0[r] = __builtin_amdgcn_exp2f(p0[r]);
    asm volatile("" : "+v"(p0));
  } else {
#pragma unroll
    for (int r = 6; r < 16; ++r) p0[r] = __builtin_amdgcn_exp2f(p0[r]);
    asm volatile("" : "+v"(p0));
  }
}
DEV void partialSM(f32x16& p0, f32x16& p1, float& m_reg, float& mn, float& alpha) {
  float pmax, mnC;
  partialSM_part<0>(p0, p1, m_reg, mn, alpha, pmax, mnC); partialSM_part<1>(p0, p1, m_reg, mn, alpha, pmax, mnC);
  partialSM_part<2>(p0, p1, m_reg, mn, alpha, pmax, mnC); partialSM_part<3>(p0, p1, m_reg, mn, alpha, pmax, mnC);
}
struct FinSM { float ps; };
#define PK4(P, BASE, OUT) do { u32x4 w = {cvtpk(P[BASE + 0], P[BASE + 1]), cvtpk(P[BASE + 2], P[BASE + 3]), cvtpk(P[BASE + 4], P[BASE + 5]), cvtpk(P[BASE + 6], P[BASE + 7])}; \
    OUT = *reinterpret_cast<bf16x8*>(&w); } while (0)
template <int ST> DEV void finishSM_part(f32x16& p0, f32x16& p1, float alpha, float& l_reg, float& ps, bf16x8& pa0, bf16x8& pa1, bf16x8& pa2, bf16x8& pa3) {
  if constexpr (ST < 8) {
    p1[2 * ST] = __builtin_amdgcn_exp2f(p1[2 * ST]); p1[2 * ST + 1] = __builtin_amdgcn_exp2f(p1[2 * ST + 1]);
    if constexpr (ST == 0) ps = p0[0] + p0[1]; else ps += p0[2 * ST] + p0[2 * ST + 1];
    if constexpr (ST > 0) ps += p1[2 * ST - 2] + p1[2 * ST - 1];
  } else if constexpr (ST == 8) {
    ps += p1[14] + p1[15];
    { auto rr = __builtin_amdgcn_permlane32_swap(__float_as_uint(ps), __float_as_uint(ps), false, false);
      ps = __uint_as_float(rr[0]) + __uint_as_float(rr[1]); }
    l_reg = l_reg * alpha + ps;
    PK4(p0, 0, pa0);
  } else if constexpr (ST == 9) { PK4(p0, 8, pa1); }
  else if constexpr (ST == 10) { PK4(p1, 0, pa2); }
  else { PK4(p1, 8, pa3); }
}
DEV void finishSM(f32x16& p0, f32x16& p1, float alpha, float& l_reg, bf16x8& pa0, bf16x8& pa1, bf16x8& pa2, bf16x8& pa3) {
  float ps;
  finishSM_part<0>(p0, p1, alpha, l_reg, ps, pa0, pa1, pa2, pa3); finishSM_part<1>(p0, p1, alpha, l_reg, ps, pa0, pa1, pa2, pa3); finishSM_part<2>(p0, p1, alpha, l_reg, ps, pa0, pa1, pa2, pa3);
  finishSM_part<3>(p0, p1, alpha, l_reg, ps, pa0, pa1, pa2, pa3); finishSM_part<4>(p0, p1, alpha, l_reg, ps, pa0, pa1, pa2, pa3); finishSM_part<5>(p0, p1, alpha, l_reg, ps, pa0, pa1, pa2, pa3);
  finishSM_part<6>(p0, p1, alpha, l_reg, ps, pa0, pa1, pa2, pa3); finishSM_part<7>(p0, p1, alpha, l_reg, ps, pa0, pa1, pa2, pa3); finishSM_part<8>(p0, p1, alpha, l_reg, ps, pa0, pa1, pa2, pa3);
  finishSM_part<9>(p0, p1, alpha, l_reg, ps, pa0, pa1, pa2, pa3); finishSM_part<10>(p0, p1, alpha, l_reg, ps, pa0, pa1, pa2, pa3); finishSM_part<11>(p0, p1, alpha, l_reg, ps, pa0, pa1, pa2, pa3);
}
template <int OFF> DEV bf16x8 rd128(int a) { bf16x8 r; asm volatile("ds_read_b128 %0, %1 offset:%2" : "=&v"(r) : "v"(a), "i"(OFF) : "memory"); return r; }
DEV void qkt(f32x16& p0, f32x16& p1, int ka0, int ra0, int kof, int rof, const bf16x8* qr) {
  const int ka = ka0 + kof, ra = ra0 + rof;
  p0 = f32x16{}; p1 = f32x16{};
  bf16x8 f[2][2];
#define RDK(d, s) do { const int a_ = ka ^ ((d) * 32); f[s][0] = rd128<0>(a_); f[s][1] = rd128<8192>(a_); } while (0)
#define RDR(d, s) do { const int a_ = ra ^ ((d) * 32); f[s][0] = rd128<0>(a_); f[s][1] = rd128<4096>(a_); } while (0)
#define WAIT2(s) asm volatile("s_waitcnt lgkmcnt(2)" : "+v"(f[s][0]), "+v"(f[s][1]) :: "memory")
#define WAIT0(s) asm volatile("s_waitcnt lgkmcnt(0)" : "+v"(f[s][0]), "+v"(f[s][1]) :: "memory")
#define MMA(d, s) do { p0 = __builtin_amdgcn_mfma_f32_32x32x16_bf16(f[s][0], qr[d], p0, 0, 0, 0); p1 = __builtin_amdgcn_mfma_f32_32x32x16_bf16(f[s][1], qr[d], p1, 0, 0, 0); } while (0)
  RDK(0, 0);
  RDK(1, 1); WAIT2(0); MMA(0, 0);
  RDK(2, 0); WAIT2(1); MMA(1, 1);
  RDK(3, 1); WAIT2(0); MMA(2, 0);
  RDK(4, 0); WAIT2(1); MMA(3, 1);
  RDK(5, 1); WAIT2(0); MMA(4, 0);
  RDK(6, 0); WAIT2(1); MMA(5, 1);
  RDK(7, 1); WAIT2(0); MMA(6, 0);
  RDR(0, 0); WAIT2(1); MMA(7, 1);
  RDR(1, 1); WAIT2(0); MMA(8, 0);
  RDR(2, 0); WAIT2(1); MMA(9, 1);
  RDR(3, 1); WAIT2(0); MMA(10, 0);
  WAIT0(1); MMA(11, 1);
#undef RDK
#undef RDR
#undef WAIT2
#undef WAIT0
#undef MMA
}
DEV void qkt_fin(f32x16& p0, f32x16& p1, int ka0, int ra0, int kof, int rof, const bf16x8* qr,
                 f32x16& f0, f32x16& f1, float alpha, float& l_reg, bf16x8& pa0, bf16x8& pa1, bf16x8& pa2, bf16x8& pa3) {
  const int ka = ka0 + kof, ra = ra0 + rof;
  p0 = f32x16{}; p1 = f32x16{};
  bf16x8 f[2][2]; float ps;
#define RDK(d, s) do { const int a_ = ka ^ ((d) * 32); f[s][0] = rd128<0>(a_); f[s][1] = rd128<8192>(a_); } while (0)
#define RDR(d, s) do { const int a_ = ra ^ ((d) * 32); f[s][0] = rd128<0>(a_); f[s][1] = rd128<4096>(a_); } while (0)
#define WAIT2(s) asm volatile("s_waitcnt lgkmcnt(2)" : "+v"(f[s][0]), "+v"(f[s][1]) :: "memory")
#define WAIT0(s) asm volatile("s_waitcnt lgkmcnt(0)" : "+v"(f[s][0]), "+v"(f[s][1]) :: "memory")
#define MMA(d, s) do { p0 = __builtin_amdgcn_mfma_f32_32x32x16_bf16(f[s][0], qr[d], p0, 0, 0, 0); p1 = __builtin_amdgcn_mfma_f32_32x32x16_bf16(f[s][1], qr[d], p1, 0, 0, 0); \
    SBAR(); finishSM_part<d>(f0, f1, alpha, l_reg, ps, pa0, pa1, pa2, pa3); SBAR(); } while (0)
  RDK(0, 0);
  RDK(1, 1); WAIT2(0); MMA(0, 0);
  RDK(2, 0); WAIT2(1); MMA(1, 1);
  RDK(3, 1); WAIT2(0); MMA(2, 0);
  RDK(4, 0); WAIT2(1); MMA(3, 1);
  RDK(5, 1); WAIT2(0); MMA(4, 0);
  RDK(6, 0); WAIT2(1); MMA(5, 1);
  RDK(7, 1); WAIT2(0); MMA(6, 0);
  RDR(0, 0); WAIT2(1); MMA(7, 1);
  RDR(1, 1); WAIT2(0); MMA(8, 0);
  RDR(2, 0); WAIT2(1); MMA(9, 1);
  RDR(3, 1); WAIT2(0); MMA(10, 0);
  WAIT0(1); MMA(11, 1);
#undef RDK
#undef RDR
#undef WAIT2
#undef WAIT0
#undef MMA
}
DEV int v_st(int k, int c) { const int kk = (k & ~0xC) | ((k & 4) << 1) | ((k & 8) >> 1); return ((kk >> 3) * 4 + (c >> 5)) * 512 + ((kk & 7) * 32 + (c & 31)) * 2; }
DEV int v_rd_base(int lane) { return ((lane & 3) << 3) | (((lane >> 2) & 3) << 6) | (((lane >> 4) & 1) << 5) | (((lane >> 5) & 1) << 8); }
constexpr int v_rd_off(int d0, int ks, int half) { return d0 * 512 + ks * 4096 + half * 2048; }
template <int OFF> DEV s16x4 tr_read(int vb) {
  s16x4 r; asm volatile("ds_read_b64_tr_b16 %0, %1 offset:%2" : "=&v"(r) : "v"(vb), "i"(OFF) : "memory"); return r;
}
template <int D0> DEV void pv_one(f32x16& od, int vb, bf16x8 pa0, bf16x8 pa1, bf16x8 pa2, bf16x8 pa3) {
  const s16x4 l0 = tr_read<v_rd_off(D0, 0, 0)>(vb), h0 = tr_read<v_rd_off(D0, 0, 1)>(vb), l1 = tr_read<v_rd_off(D0, 1, 0)>(vb), h1 = tr_read<v_rd_off(D0, 1, 1)>(vb);
  const s16x4 l2 = tr_read<v_rd_off(D0, 2, 0)>(vb), h2 = tr_read<v_rd_off(D0, 2, 1)>(vb), l3 = tr_read<v_rd_off(D0, 3, 0)>(vb), h3 = tr_read<v_rd_off(D0, 3, 1)>(vb);
  asm volatile("s_waitcnt lgkmcnt(0)" ::: "memory"); SBAR();
#define PK(L, H) (bf16x8){L[0], L[1], L[2], L[3], H[0], H[1], H[2], H[3]}
  od = __builtin_amdgcn_mfma_f32_32x32x16_bf16(pa0, PK(l0, h0), od, 0, 0, 0);
  od = __builtin_amdgcn_mfma_f32_32x32x16_bf16(pa1, PK(l1, h1), od, 0, 0, 0);
  od = __builtin_amdgcn_mfma_f32_32x32x16_bf16(pa2, PK(l2, h2), od, 0, 0, 0);
  od = __builtin_amdgcn_mfma_f32_32x32x16_bf16(pa3, PK(l3, h3), od, 0, 0, 0);
#undef PK
}
DEV void pv_d0(f32x16* o, int vb, bf16x8 pa0, bf16x8 pa1, bf16x8 pa2, bf16x8 pa3) {
  pv_one<0>(o[0], vb, pa0, pa1, pa2, pa3); pv_one<1>(o[1], vb, pa0, pa1, pa2, pa3); pv_one<2>(o[2], vb, pa0, pa1, pa2, pa3); pv_one<3>(o[3], vb, pa0, pa1, pa2, pa3);
}

struct VFrag { s16x4 l0, h0, l1, h1, l2, h2, l3, h3; };
template <int D0> DEV void pv_read(VFrag& f, int vb) {
  f.l0 = tr_read<v_rd_off(D0, 0, 0)>(vb); f.h0 = tr_read<v_rd_off(D0, 0, 1)>(vb); f.l1 = tr_read<v_rd_off(D0, 1, 0)>(vb); f.h1 = tr_read<v_rd_off(D0, 1, 1)>(vb);
  f.l2 = tr_read<v_rd_off(D0, 2, 0)>(vb); f.h2 = tr_read<v_rd_off(D0, 2, 1)>(vb); f.l3 = tr_read<v_rd_off(D0, 3, 0)>(vb); f.h3 = tr_read<v_rd_off(D0, 3, 1)>(vb);
}
DEV void pv_wait(VFrag& f) {
  asm volatile("s_waitcnt lgkmcnt(0)" : "+v"(f.l0), "+v"(f.h0), "+v"(f.l1), "+v"(f.h1), "+v"(f.l2), "+v"(f.h2), "+v"(f.l3), "+v"(f.h3) :: "memory");
}
DEV void pv_mma(f32x16& od, const VFrag& f, bf16x8 pa0, bf16x8 pa1, bf16x8 pa2, bf16x8 pa3) {
#define PK(L, H) (bf16x8){L[0], L[1], L[2], L[3], H[0], H[1], H[2], H[3]}
  od = __builtin_amdgcn_mfma_f32_32x32x16_bf16(pa0, PK(f.l0, f.h0), od, 0, 0, 0);
  od = __builtin_amdgcn_mfma_f32_32x32x16_bf16(pa1, PK(f.l1, f.h1), od, 0, 0, 0);
  od = __builtin_amdgcn_mfma_f32_32x32x16_bf16(pa2, PK(f.l2, f.h2), od, 0, 0, 0);
  od = __builtin_amdgcn_mfma_f32_32x32x16_bf16(pa3, PK(f.l3, f.h3), od, 0, 0, 0);
#undef PK
}
DEV void pv_psm(f32x16* o, int vb, bf16x8 pa0, bf16x8 pa1, bf16x8 pa2, bf16x8 pa3, f32x16& q0, f32x16& q1, float& m_reg, float& mn, float& alpha) {
  VFrag fa, fb; float pmax, mnC;
  pv_read<0>(fa, vb);
  pv_wait(fa); pv_mma(o[0], fa, pa0, pa1, pa2, pa3); pv_read<1>(fb, vb); SBAR(); partialSM_part<0>(q0, q1, m_reg, mn, alpha, pmax, mnC); SBAR();
  pv_wait(fb); pv_mma(o[1], fb, pa0, pa1, pa2, pa3); pv_read<2>(fa, vb); SBAR(); partialSM_part<1>(q0, q1, m_reg, mn, alpha, pmax, mnC); SBAR();
  pv_wait(fa); pv_mma(o[2], fa, pa0, pa1, pa2, pa3); pv_read<3>(fb, vb); SBAR(); partialSM_part<2>(q0, q1, m_reg, mn, alpha, pmax, mnC); SBAR();
  pv_wait(fb); pv_mma(o[3], fb, pa0, pa1, pa2, pa3); SBAR(); partialSM_part<3>(q0, q1, m_reg, mn, alpha, pmax, mnC); SBAR();
}
DEV void attn_unit(const bf16* __restrict__ Qb, const bf16* __restrict__ Kh, const bf16* __restrict__ Vh, const bf16* __restrict__ Rh, bf16* __restrict__ Ob, int seq, char* lds, LAS unsigned char* ldsl, int tid_in) {
  int tid_ = tid_in; asm volatile("" : "+v"(tid_));
  const int tid = tid_, wid = __builtin_amdgcn_readfirstlane(tid >> 6), lane = tid & 63, r32 = lane & 31, hi = lane >> 5;
  float* ws = (float*)(lds + OFF_WS) + wid * 64; float* li_l = ws; float* al_l = ws + 32;
  if (wid >= 4) __builtin_amdgcn_s_setprio(1);
  float m_reg = -1e30f, l_reg = 0; f32x16 o[4] = {}; bf16x8 qr[12];
  const bf16* Qw = Qb + (long)(wid * QBLK + r32) * LDQ + hi * 8;
#pragma unroll
  for (int d0 = 0; d0 < 12; ++d0) qr[d0] = ld8(Qw + d0 * 16);
  const int vb0 = (int)(uintptr_t)(lds + OFF_V) + v_rd_base(lane);
  const int ka = (int)(uintptr_t)(lds + OFF_K) + r32 * 256 + ((hi * 16) ^ ((r32 & 15) << 4)), ra = (int)(uintptr_t)(lds + OFF_R) + r32 * 128 + ((hi * 16) ^ (((r32 >> 1) & 7) << 4));
  const int NT = seq / KVBLK;
#define DMA16(gp, lp) __builtin_amdgcn_global_load_lds((const unsigned*)(gp), (LAS unsigned*)(lp), 16, 0, 0)
#define DMA_SRC() const int ln_ = lane;   \
    int kof_[2], vof_[2]; _Pragma("unroll") for (int i = 0; i < 2; ++i) { const int n = 2 * wid + i; \
      { const int row = 4 * n + (ln_ >> 4), colB = ((ln_ & 15) * 16) ^ ((row & 15) << 4); kof_[i] = row * 256 + colB; } \
      { const int blk = 2 * n + (ln_ >> 5), kk = (blk >> 2) * 8 + ((ln_ & 31) >> 2), c = (blk & 3) * 32 + 8 * (ln_ & 3); vof_[i] = kk * 256 + c * 2;   } } \
    const int rrow_ = 8 * wid + (ln_ >> 3), rof_ = rrow_ * 128 + (((ln_ & 7) * 16) ^ (((rrow_ >> 1) & 7) << 4));
#define DMA_KR(t, b) do { const int tt = (t) < NT ? (t) : NT - 1; const char* kp = (const char*)Kh + (size_t)tt * (KVBLK * 256); const char* rp = (const char*)Rh + (size_t)tt * (KVBLK * 128); \
    DMA16(kp + kof_[0], ldsl + OFF_K + (b) * SHM_K + (2 * wid) * 1024); DMA16(kp + kof_[1], ldsl + OFF_K + (b) * SHM_K + (2 * wid + 1) * 1024); DMA16(rp + rof_, ldsl + OFF_R + (b) * SHM_R + wid * 1024); } while (0)
#define DMA_V(t, b) do { const int tt = (t) < NT ? (t) : NT - 1; const char* vp = (const char*)Vh + (size_t)tt * (KVBLK * 256); \
    DMA16(vp + vof_[0], ldsl + OFF_V + (b) * SHM_V + (2 * wid) * 1024); DMA16(vp + vof_[1], ldsl + OFF_V + (b) * SHM_V + (2 * wid + 1) * 1024); } while (0)
#define WAITV(n) asm volatile("s_waitcnt vmcnt(" #n ")" ::: "memory")
#define NEXTB(b) ((b) == NBUF - 1 ? 0 : (b) + 1)
#define RESC(a) do { if (__any((a) < 1.f)) { if (hi == 0) al_l[r32] = (a); asm volatile("s_waitcnt lgkmcnt(0)" ::: "memory"); \
    _Pragma("unroll") for (int d = 0; d < 4; ++d) _Pragma("unroll") for (int r = 0; r < 16; ++r) o[d][r] *= al_l[crow(r, hi)]; } } while (0)
  f32x16 pA0, pA1, pB0, pB1; float mnA, mnB, alA, alB; bf16x8 pa0, pa1, pa2, pa3;
  DMA_SRC();
  DMA_KR(0, 0); DMA_KR(1, 1); DMA_V(0, 0); DMA_KR(2, 2); DMA_V(1, 1);
  WAITV(10); __builtin_amdgcn_s_barrier(); asm volatile("" ::: "memory");
  qkt(pA0, pA1, ka, ra, 0, 0, qr); partialSM(pA0, pA1, m_reg, mnA, alA);
  int bt = 0;
#define HALF(t, X0, X1, alX, Y0, Y1, mnY, alY) do { \
    WAITV(5); __builtin_amdgcn_s_barrier(); asm volatile("" ::: "memory"); \
    const int b1 = NEXTB(bt), b2 = NEXTB(b1); \
    DMA_KR((t) + 3, bt); DMA_V((t) + 2, b2); \
    SBAR(); qkt_fin(Y0, Y1, ka, ra, b1 * SHM_K, b1 * SHM_R, qr, X0, X1, alX, l_reg, pa0, pa1, pa2, pa3); SBAR(); \
    pv_psm(o, vb0 + bt * SHM_V, pa0, pa1, pa2, pa3, Y0, Y1, m_reg, mnY, alY); \
    RESC(alY); bt = b1; } while (0)
  int t = 0;
  for (; t + 2 < NT; t += 2) {
    HALF(t, pA0, pA1, alA, pB0, pB1, mnB, alB);
    HALF(t + 1, pB0, pB1, alB, pA0, pA1, mnA, alA);
  }
  HALF(t, pA0, pA1, alA, pB0, pB1, mnB, alB);
  WAITV(0); __builtin_amdgcn_s_barrier(); asm volatile("" ::: "memory");
  finishSM(pB0, pB1, alB, l_reg, pa0, pa1, pa2, pa3); SBAR();
  pv_d0(o, vb0 + bt * SHM_V, pa0, pa1, pa2, pa3);
  if (hi == 0) li_l[r32] = l_reg; asm volatile("s_waitcnt lgkmcnt(0)" ::: "memory");
  float rli[16];
#pragma unroll
  for (int r = 0; r < 16; ++r) rli[r] = __builtin_amdgcn_rcpf(li_l[crow(r, hi)]);
  bf16* Ow = Ob + (long)(wid * QBLK) * LDO;
  LAS unsigned char* ot = ldsl + OFF_K + wid * 8192;
  { LAS unsigned char* ob = ot + hi * 1024 + r32 * 2;
#pragma unroll
    for (int r = 0; r < 16; ++r)
#pragma unroll
      for (int d0 = 0; d0 < 4; ++d0) *(LAS bf16*)(ob + ((r & 3) + 8 * (r >> 2)) * 256 + d0 * 64) = (bf16)f2bf(o[d0][r] * rli[r]); }
#pragma unroll
  for (int i = 0; i < 8; ++i) { const int c = i * 64 + lane, row = c >> 4, cc = c & 15;
    const u32x4 w = *(const LAS u32x4*)(ot + row * 256 + cc * 16); *(GAS u32x4*)(Ow + (long)row * LDO + cc * 8) = w; }
  __builtin_amdgcn_s_setprio(0);
  __syncthreads();
#undef DMA16
#undef DMA_SRC
#undef DMA_KR
#undef DMA_V
#undef WAITV
#undef NEXTB
#undef HALF
#undef RESC
}
#undef KSWZ
#undef RSWZ
}
#ifndef DBG_ML
#define DBG_ML 0
#endif
DEV f32x4 mfma16(bf16x8 a, bf16x8 b, f32x4 c) { return __builtin_amdgcn_mfma_f32_16x16x32_bf16(a, b, c, 0, 0, 0); }
DEV bf16x8 frag_row(const LAS unsigned char* T, int st, int row0, int k0, int lane) {
    return *(const LAS bf16x8*)(T + (row0 + (lane & 15)) * st + (k0 + 8 * (lane >> 4)) * 2);
}
DEV bf16x8 frag_tr(const LAS unsigned char* T, int st, int k0, int col0, int lane) {
    const int g = lane >> 4, q = (lane & 15) >> 2, p = lane & 3;
    const LAS unsigned char* a = T + (k0 + 8 * g + q) * st + (col0 + 4 * p) * 2;
    const s16x4 lo = __builtin_bit_cast(s16x4, __builtin_amdgcn_ds_read_tr16_b64_v4i16((LAS s16x4*)a));
    const s16x4 hi = __builtin_bit_cast(s16x4, __builtin_amdgcn_ds_read_tr16_b64_v4i16((LAS s16x4*)(a + 4 * st)));
    return (bf16x8){lo[0], lo[1], lo[2], lo[3], hi[0], hi[1], hi[2], hi[3]};
}
DEV bf16x8 frag_scale(bf16x8 a, float f) {
    const u32x4 w = __builtin_bit_cast(u32x4, a); u32x4 o;
    o.x = pk2(bflo(w.x) * f, bfhi(w.x) * f); o.y = pk2(bflo(w.y) * f, bfhi(w.y) * f); o.z = pk2(bflo(w.z) * f, bfhi(w.z) * f); o.w = pk2(bflo(w.w) * f, bfhi(w.w) * f);
    return __builtin_bit_cast(bf16x8, o);
}
DEV bf16x8 frag_scale8(bf16x8 a, f32x4 f0, f32x4 f1) {
    const u32x4 w = __builtin_bit_cast(u32x4, a); u32x4 o;
    o.x = pk2(bflo(w.x) * f0[0], bfhi(w.x) * f0[1]); o.y = pk2(bflo(w.y) * f0[2], bfhi(w.y) * f0[3]); o.z = pk2(bflo(w.z) * f1[0], bfhi(w.z) * f1[1]); o.w = pk2(bflo(w.w) * f1[2], bfhi(w.w) * f1[3]);
    return __builtin_bit_cast(bf16x8, o);
}
DEV bf16x8 frag_from_f32(const float* p) {
    const f32x4 a = *(const f32x4*)p, b = *(const f32x4*)(p + 4);
    u32x4 w; w.x = pk2(a[0], a[1]); w.y = pk2(a[2], a[3]); w.z = pk2(b[0], b[1]); w.w = pk2(b[2], b[3]); return __builtin_bit_cast(bf16x8, w);
}
template <bool MAXOP> DEV void wave_scan2(float x0, float x1, int lane, float& r0, float& r1, float& tot) {
    float s = MAXOP ? fmaxf(x0, x1) : x0 + x1;
#pragma unroll
    for (int o = 1; o < 64; o <<= 1) { const float t = shup(s, o, lane); if (lane >= o) s = MAXOP ? fmaxf(s, t) : s + t; }
    float e = shup(s, 1, lane); if (lane == 0) e = MAXOP ? -3.0e38f : 0.f;
    r0 = MAXOP ? fmaxf(e, x0) : e + x0; r1 = s; tot = __uint_as_float(__builtin_amdgcn_readlane(__float_as_uint(s), 63));
}

constexpr int ST128 = 272, ST256 = 528;

DEV void stage_tile(LAS unsigned char* T, int st, const bf16* g, size_t gst, int rows, int cols, float scale, int tid) {
    const int cpr = cols >> 3, n = rows * cpr;
    for (int i = tid; i < n; i += 512) { const int r = i / cpr, c = i - r * cpr; u32x4 w = *(const u32x4*)(g + (size_t)r * gst + c * 8);
        if (scale != 1.f) { float v[8]; unpack8(w, v);
#pragma unroll
            for (int e = 0; e < 8; ++e) v[e] *= scale; w = pack8(v); }
        *(LAS u32x4*)(T + r * st + c * 16) = w; }
}
template <int COLS> DEV void stage_conv(LAS unsigned char* T, int st, const bf16* zin_b  , int s0, int zcol0, int ch0, const float* cw, const float* cb, int tid) {
    constexpr int CPR = COLS / 8, RPT = 128 * CPR / 512;
    const int c = tid % CPR, r0 = (tid / CPR) * RPT;
    f32x4 w[5][2], bias[2];
#pragma unroll
    for (int j = 0; j < 5; ++j) { w[j][0] = *(const GAS f32x4*)(cw + j * 1536 + ch0 + c * 8); w[j][1] = *(const GAS f32x4*)(cw + j * 1536 + ch0 + c * 8 + 4); }
    bias[0] = *(const GAS f32x4*)(cb + ch0 + c * 8); bias[1] = *(const GAS f32x4*)(cb + ch0 + c * 8 + 4);
    u32x4 raw[RPT + 4];
#pragma unroll
    for (int k = 0; k < RPT + 4; ++k) { const int s = s0 + r0 + k - 2; raw[k] = (u32x4){0u, 0u, 0u, 0u};
        if (s >= 0 && s < SEQ) raw[k] = *(const GAS u32x4*)(zin_b + (size_t)s * ZW + zcol0 + c * 8); }
#pragma unroll
    for (int k = 0; k < RPT; ++k) { float acc[8];
#pragma unroll
        for (int e = 0; e < 4; ++e) { acc[e] = bias[0][e]; acc[4 + e] = bias[1][e]; }
#pragma unroll
        for (int j = 0; j < 5; ++j) { float v[8]; unpack8(raw[k + j], v);
#pragma unroll
            for (int e = 0; e < 4; ++e) { acc[e] += v[e] * w[j][0][e]; acc[4 + e] += v[4 + e] * w[j][1][e]; } }
#pragma unroll
        for (int e = 0; e < 8; ++e) acc[e] = siluf_(acc[e]);
        *(LAS u32x4*)(T + (r0 + k) * st + c * 16) = pack8(acc); }
}

DEV void mlstm_state_unit(const Params& P, const Ctx& C0, int L, int unit) {
    const Ctx C = fresh(C0);
    const int b = unit >> 8, h = (unit >> 6) & 3, ch = unit & 63, tid = C.tid, lane = C.lane, wave = C.wave, fq = lane >> 4;
    const size_t tok0 = (size_t)b * SEQ + ch * 128;
    const bf16* ZIN = (const bf16*)(C.ws + WS_ZIN); const float* SMALL = (const float*)(C.ws + WS_SMALL);
    float* misc = (float*)(C.ws + WS_MISC);
    LAS unsigned char* KS = C.lds; LAS unsigned char* VS = C.lds + 128 * ST128; LAS float* EE = (LAS float*)(C.lds + 128 * ST128 + 128 * ST256);
    if (wave < 2) { const int d = wave, idx = ((b * 4 + h) * 2 + d) * 64 + ch;
        const float big = P.in[I_BIG][L * 8 + d * 4 + h], bfg = P.in[I_BFG][L * 8 + d * 4 + h];
        const int j0 = 2 * lane, j1 = j0 + 1, i0 = d ? 127 - j0 : j0, i1 = d ? 127 - j1 : j1;
        const float li0 = SMALL[(tok0 + i0) * SMW + d * 4 + h] + big, li1 = SMALL[(tok0 + i1) * SMW + d * 4 + h] + big;
        const float lf0 = logsigf_(SMALL[(tok0 + i0) * SMW + 8 + d * 4 + h] + bfg), lf1 = logsigf_(SMALL[(tok0 + i1) * SMW + 8 + d * 4 + h] + bfg);
        float b0, b1, g; wave_scan2<false>(lf0, lf1, lane, b0, b1, g);
        const float w0 = g - b0 + li0, w1 = g - b1 + li1; const float m = wave_max(fmaxf(w0, w1), lane);
        EE[d * 128 + i0] = __expf(w0 - m); EE[d * 128 + i1] = __expf(w1 - m);
        if (lane == 0) { misc[OFF_MLOC / 4 + idx] = m; misc[OFF_MG / 4 + idx] = g; }
    }
    stage_tile(KS, ST128, ZIN + tok0 * ZW + ZC_AK + h * 128, ZW, 128, 128, 0.08838834764831845f, tid);
    stage_tile(VS, ST256, ZIN + tok0 * ZW + ZC_AV + h * 256, ZW, 128, 256, 1.f, tid);
    __syncthreads();
    {
        const int dk = tid >> 2, part = tid & 3; float s0 = 0.f, s1 = 0.f;
#pragma unroll 8
        for (int i = 0; i < 32; ++i) { const int r = part * 32 + i; const float kv = bf2f(*(const LAS unsigned short*)(KS + r * ST128 + dk * 2)); s0 += kv * EE[r]; s1 += kv * EE[128 + r]; }
        s0 += shx(s0, 1, lane); s0 += shx(s0, 2, lane); s1 += shx(s1, 1, lane); s1 += shx(s1, 2, lane);
        if (part == 0) { const int idx0 = ((b * 4 + h) * 2) * 64 + ch; misc[OFF_NLOC / 4 + (size_t)idx0 * 128 + dk] = s0; misc[OFF_NLOC / 4 + (size_t)(idx0 + 64) * 128 + dk] = s1; } }
    for (int d = 0; d < 2; ++d) {
        const int idx = ((b * 4 + h) * 2 + d) * 64 + ch;
        f32x4 acc[8][2];
#pragma unroll
        for (int a = 0; a < 8; ++a) { acc[a][0] = (f32x4){0.f, 0.f, 0.f, 0.f}; acc[a][1] = (f32x4){0.f, 0.f, 0.f, 0.f}; }
#pragma unroll 1
        for (int ks = 0; ks < 4; ++ks) { const bf16x8 bv0 = frag_tr(VS, ST256, 32 * ks, 32 * wave, lane), bv1 = frag_tr(VS, ST256, 32 * ks, 32 * wave + 16, lane);
            const f32x4 e0 = *(const LAS f32x4*)(EE + d * 128 + 32 * ks + 8 * fq), e1 = *(const LAS f32x4*)(EE + d * 128 + 32 * ks + 8 * fq + 4);
#pragma unroll
            for (int kt = 0; kt < 8; ++kt) { const bf16x8 a = frag_scale8(frag_tr(KS, ST128, 32 * ks, 16 * kt, lane), e0, e1); acc[kt][0] = mfma16(a, bv0, acc[kt][0]); acc[kt][1] = mfma16(a, bv1, acc[kt][1]); } }
        bf16* CL = (bf16*)(C.ws + WS_CLOC) + (size_t)idx * 32768;
#pragma unroll
        for (int kt = 0; kt < 8; ++kt)
#pragma unroll
            for (int nt = 0; nt < 2; ++nt) { u32x2 w; w.x = pk2(acc[kt][nt][0], acc[kt][nt][1]); w.y = pk2(acc[kt][nt][2], acc[kt][nt][3]);
                *(GAS u32x2*)(CL + (size_t)(32 * wave + 16 * nt + (lane & 15)) * 128 + 16 * kt + 4 * (lane >> 4)) = w; }
    }
    __syncthreads();
}

DEV void mlstm_scan(const Ctx& C0) {
    const Ctx C = fresh(C0);
    float* misc = (float*)(C.ws + WS_MISC); const float* MLOC = misc + OFF_MLOC / 4; const float* MG = misc + OFF_MG / 4; float* M0 = misc + OFF_M0 / 4; float* NL = misc + OFF_NLOC / 4;
    bf16* CL = (bf16*)(C.ws + WS_CLOC);
    const int nthreads = C.G * 512;
    for (int t = C.bid * 512 + C.tid; t < 16 * 8192; t += nthreads) {
        const int chain = t >> 13, e4 = t & 8191, d = chain & 1; const bool hasn = e4 < 32;
        f32x4 st = (f32x4){0.f, 0.f, 0.f, 0.f}, sn = (f32x4){0.f, 0.f, 0.f, 0.f}; float m = 0.f;
        bf16* base = CL + (size_t)chain * 64 * 32768 + e4 * 4; float* nbase = NL + (size_t)chain * 64 * 128 + (e4 & 31) * 4;
        for (int s8 = 0; s8 < 64; s8 += 16) { u32x2 x[16]; f32x4 xn[16];
#pragma unroll
            for (int k = 0; k < 16; ++k) { const int ch = d ? 63 - (s8 + k) : s8 + k; x[k] = *(const GAS u32x2*)(base + (size_t)ch * 32768);
                xn[k] = (f32x4){0.f, 0.f, 0.f, 0.f}; if (hasn) xn[k] = *(const GAS f32x4*)(nbase + (size_t)ch * 128); }
#pragma unroll
            for (int k = 0; k < 16; ++k) { const int ch = d ? 63 - (s8 + k) : s8 + k; const float g = MG[chain * 64 + ch], ml = MLOC[chain * 64 + ch];
                u32x2 w; w.x = pk2(st[0], st[1]); w.y = pk2(st[2], st[3]); *(GAS u32x2*)(base + (size_t)ch * 32768) = w;
                if (hasn) { *(GAS f32x4*)(nbase + (size_t)ch * 128) = sn; if (e4 == 0) M0[chain * 64 + ch] = m; }
                const float mn = fmaxf(g + m, ml), ap = __expf(g + m - mn), al = __expf(ml - mn);
                st = st * ap + (f32x4){bflo(x[k].x), bfhi(x[k].x), bflo(x[k].y), bfhi(x[k].y)} * al; sn = sn * ap + xn[k] * al; m = mn; } }
    }
}

DEV void mlstm_out_unit(const Params& P, const Ctx& C0, int L, int unit) {
    const Ctx C = fresh(C0);
    const int b = unit >> 8, h = (unit >> 6) & 3, ch = unit & 63, tid = C.tid, lane = C.lane, wave = C.wave, fr = lane & 15, fq = lane >> 4;
    const size_t tok0 = (size_t)b * SEQ + ch * 128;
    const bf16* ZIN = (const bf16*)(C.ws + WS_ZIN); const float* SMALL = (const float*)(C.ws + WS_SMALL); const float* misc = (const float*)(C.ws + WS_MISC);
    LAS unsigned char* QS = C.lds; LAS unsigned char* KP = C.lds + 128 * ST128; LAS unsigned char* VS = C.lds + 2 * 128 * ST128;
    LAS float* vec = (LAS float*)(C.lds + 2 * 128 * ST128 + 128 * ST256);
    LAS float* AVb = vec, *MXb = vec + 256, *EIb = vec + 512, *FLb = vec + 768, *QNb = vec + 1024, *FQ = vec + 1280, *SSQ = vec + 1408;
    if (wave < 2) {
        const int d = wave, idx = ((b * 4 + h) * 2 + d) * 64 + ch;
        const float big = P.in[I_BIG][L * 8 + d * 4 + h], bfg = P.in[I_BFG][L * 8 + d * 4 + h], m0 = misc[OFF_M0 / 4 + idx];
        const int j0 = 2 * lane, j1 = j0 + 1, i0 = d ? 127 - j0 : j0, i1 = d ? 127 - j1 : j1;
        const float li0 = SMALL[(tok0 + i0) * SMW + d * 4 + h] + big, li1 = SMALL[(tok0 + i1) * SMW + d * 4 + h] + big;
        const float lf0 = logsigf_(SMALL[(tok0 + i0) * SMW + 8 + d * 4 + h] + bfg), lf1 = logsigf_(SMALL[(tok0 + i1) * SMW + 8 + d * 4 + h] + bfg);
        float b0, b1, g; wave_scan2<false>(lf0, lf1, lane, b0, b1, g);
        const float a0 = li0 - b0, a1 = li1 - b1; float p0, p1, pt; wave_scan2<true>(a0, a1, lane, p0, p1, pt);
        const float x0 = fmaxf(m0, p0), x1 = fmaxf(m0, p1);
        LAS float* AV = AVb + d * 128, *MX = MXb + d * 128, *EI = EIb + d * 128, *FL = FLb + d * 128;
        AV[i0] = a0; AV[i1] = a1; MX[i0] = x0; MX[i1] = x1; EI[i0] = __expf(m0 - x0); EI[i1] = __expf(m0 - x1); FL[i0] = __expf(-(b0 + x0)); FL[i1] = __expf(-(b1 + x1));
    }
    stage_tile(QS, ST128, ZIN + tok0 * ZW + ZC_AQ + h * 128, ZW, 128, 128, 1.f, tid);
    stage_tile(KP, ST128, ZIN + tok0 * ZW + ZC_AK + h * 128, ZW, 128, 128, 0.08838834764831845f, tid);
    stage_tile(VS, ST256, ZIN + tok0 * ZW + ZC_AV + h * 256, ZW, 128, 256, 1.f, tid);
    __syncthreads();
    f32x4 sreg[8];
#pragma unroll
    for (int st = 0; st < 8; ++st) sreg[st] = (f32x4){0.f, 0.f, 0.f, 0.f};
#pragma unroll
    for (int ks = 0; ks < 4; ++ks) { const bf16x8 bq = frag_row(QS, ST128, 16 * wave, 32 * ks, lane);
#pragma unroll
        for (int st = 0; st < 8; ++st) sreg[st] = mfma16(frag_row(KP, ST128, 16 * st, 32 * ks, lane), bq, sreg[st]); }
#pragma unroll
    for (int d = 0; d < 2; ++d) {
        const int idx = ((b * 4 + h) * 2 + d) * 64 + ch, r = tid >> 2, part = tid & 3; const float* n0 = misc + OFF_NLOC / 4 + (size_t)idx * 128 + part * 32; float s = 0.f;
#pragma unroll
        for (int c = 0; c < 4; ++c) { float v[8]; unpack8(*(const LAS u32x4*)(QS + r * ST128 + (part * 32 + c * 8) * 2), v);
            const f32x4 n0a = *(const GAS f32x4*)(n0 + c * 8), n0b = *(const GAS f32x4*)(n0 + c * 8 + 4);
#pragma unroll
            for (int e = 0; e < 4; ++e) s += v[e] * n0a[e] + v[4 + e] * n0b[e]; }
        s += shx(s, 1, lane); s += shx(s, 2, lane); if (part == 0) QNb[d * 128 + r] = s;
    }
    f32x4 acc[8][2];
#pragma unroll
    for (int a = 0; a < 8; ++a) { acc[a][0] = (f32x4){0.f, 0.f, 0.f, 0.f}; acc[a][1] = (f32x4){0.f, 0.f, 0.f, 0.f}; }
    const int t = 16 * wave + fr;
    for (int d = 0; d < 2; ++d) {
        const int idx = ((b * 4 + h) * 2 + d) * 64 + ch;
        const LAS float* AV = AVb + d * 128; const LAS float* MX = MXb + d * 128; const LAS float* EI = EIb + d * 128; const LAS float* FL = FLb + d * 128; const LAS float* QN = QNb + d * 128;
        const bf16* C0 = (const bf16*)(C.ws + WS_CLOC) + (size_t)idx * 32768;
        bf16x8 bc[4][2];
#pragma unroll
        for (int ks = 0; ks < 4; ++ks)
#pragma unroll
            for (int nt = 0; nt < 2; ++nt) bc[ks][nt] = *(const GAS bf16x8*)(C0 + (size_t)(32 * wave + 16 * nt + fr) * 128 + 32 * ks + 8 * fq);
        __syncthreads();
        {
            const float mx = MX[t]; float rs = 0.f; f32x4 pr[8];
#pragma unroll
            for (int st = 0; st < 8; ++st) { const f32x4 av = *(const LAS f32x4*)(AV + 16 * st + 4 * fq);
#pragma unroll
                for (int i = 0; i < 4; ++i) { const int s = 16 * st + 4 * fq + i; const bool valid = d ? (s >= t) : (s <= t);
                    const float dd = valid ? __expf(av[i] - mx) : 0.f; pr[st][i] = sreg[st][i] * dd; rs += pr[st][i]; } }
            rs = xsum32(xsum16(rs));
            const float den = rs + EI[t] * QN[t]; const float inv = __builtin_amdgcn_rcpf(fmaxf(fabsf(den), FL[t]));
            if (fq == 0) FQ[t] = EI[t] * inv;
#pragma unroll
            for (int st = 0; st < 8; ++st) { u32x2 w; w.x = pk2(pr[st][0] * inv, pr[st][1] * inv); w.y = pk2(pr[st][2] * inv, pr[st][3] * inv);
                *(LAS u32x2*)(KP + t * ST128 + (16 * st + 4 * fq) * 2) = w; }
        }
        __syncthreads();
#pragma unroll 1
        for (int ks = 0; ks < 4; ++ks) { const bf16x8 bv0 = frag_tr(VS, ST256, 32 * ks, 32 * wave, lane), bv1 = frag_tr(VS, ST256, 32 * ks, 32 * wave + 16, lane);
#pragma unroll
            for (int tt = 0; tt < 8; ++tt) { const bf16x8 a = frag_row(KP, ST128, 16 * tt, 32 * ks, lane); if (!(DBG_ML & 1) && !((DBG_ML >> (2 + d)) & 1)) { acc[tt][0] = mfma16(a, bv0, acc[tt][0]); acc[tt][1] = mfma16(a, bv1, acc[tt][1]); } } }
#pragma unroll
        for (int ks = 0; ks < 4; ++ks) {
#pragma unroll
            for (int tt = 0; tt < 8; ++tt) { const bf16x8 a = frag_scale(frag_row(QS, ST128, 16 * tt, 32 * ks, lane), FQ[16 * tt + fr]); if (!(DBG_ML & 2) && !((DBG_ML >> (2 + d)) & 1)) { acc[tt][0] = mfma16(a, bc[ks][0], acc[tt][0]); acc[tt][1] = mfma16(a, bc[ks][1], acc[tt][1]); }
                if (tt & 1) __builtin_amdgcn_sched_barrier(0); } }
    }
#pragma unroll
    for (int tt = 0; tt < 8; ++tt)
#pragma unroll
        for (int i = 0; i < 4; ++i) { float s = acc[tt][0][i] * acc[tt][0][i] + acc[tt][1][i] * acc[tt][1][i];
            s += shx(s, 1, lane); s += shx(s, 2, lane); s += shx(s, 4, lane); s += shx(s, 8, lane);
            if (fr == 0) SSQ[wave * 128 + 16 * tt + 4 * fq + i] = s; }
    __syncthreads();
    if (tid < 128) { float s = 0.f;
#pragma unroll
        for (int w = 0; w < 8; ++w) s += SSQ[w * 128 + tid];
        FQ[tid] = rsqrtf(s * (1.f / 256.f) + EPS); }
    __syncthreads();
#pragma unroll
    for (int tt = 0; tt < 8; ++tt)
#pragma unroll
        for (int i = 0; i < 4; ++i) { const int tr = 16 * tt + 4 * fq + i; const float rstd = FQ[tr];
#pragma unroll
            for (int nt = 0; nt < 2; ++nt) *(LAS unsigned short*)(VS + tr * ST256 + (32 * wave + 16 * nt + fr) * 2) = (unsigned short)f2bf(acc[tt][nt][i] * rstd); }
    __syncthreads();
    {   const float* ng = P.in[I_MLN] + L * 1024 + h * 256; bf16* YA = (bf16*)(C.ws + WS_Y);
        u32x4 og[8];
#pragma unroll
        for (int k = 0; k < 8; ++k) { const int c = tid + 512 * k, tr = c >> 5, c8 = (c & 31) * 8; og[k] = *(const GAS u32x4*)(ZIN + (tok0 + tr) * ZW + ZC_AO + h * 256 + c8); }
#pragma unroll
        for (int k = 0; k < 8; ++k) { const int c = tid + 512 * k, tr = c >> 5, c8 = (c & 31) * 8; float hv[8], gv[8], o[8];
            unpack8(*(const LAS u32x4*)(VS + tr * ST256 + c8 * 2), hv); unpack8(og[k], gv);
            const f32x4 n0 = *(const GAS f32x4*)(ng + c8), n1 = *(const GAS f32x4*)(ng + c8 + 4);
#pragma unroll
            for (int e = 0; e < 4; ++e) { o[e] = sigmoidf_(gv[e]) * hv[e] * n0[e]; o[4 + e] = sigmoidf_(gv[4 + e]) * hv[4 + e] * n1[e]; }
            *(GAS u32x4*)(YA + (tok0 + tr) * 1024 + h * 256 + c8) = pack8(o); }
    }
    __syncthreads();
}
#ifndef DBG_SSD
#define DBG_SSD 0
#endif
DEV void ssd_vectors(const Params& P, const float* SMALL, size_t tok0, int L, int d, int hd, int lane, float& dt0, float& dt1, float& ac0, float& ac1, float& gt, int& i0, int& i1) {
    const float dtb = P.in[I_DTB][L * 32 + d * 16 + hd], A = -__expf(P.in[I_ALOG][L * 32 + d * 16 + hd]);
    const int j0 = 2 * lane, j1 = j0 + 1; i0 = d ? 127 - j0 : j0; i1 = d ? 127 - j1 : j1;
    dt0 = softplusf_(SMALL[(tok0 + i0) * SMW + 16 + d * 16 + hd] + dtb); dt1 = softplusf_(SMALL[(tok0 + i1) * SMW + 16 + d * 16 + hd] + dtb);
    wave_scan2<false>(dt0 * A, dt1 * A, lane, ac0, ac1, gt);
}
DEV void ssd_state_unit(const Params& P, const Ctx& C0, int L, int unit) {
    const Ctx C = fresh(C0);
    const int half = unit & 1, g = (unit >> 1) & 1, ch = (unit >> 2) & 63, b = unit >> 8, tid = C.tid, lane = C.lane, wave = C.wave, fr = lane & 15, fq = lane >> 4;
    const size_t tok0 = (size_t)b * SEQ + ch * 128;
    const bf16* ZINb = (const bf16*)(C.ws + WS_ZIN) + (size_t)b * SEQ * ZW; const float* SMALL = (const float*)(C.ws + WS_SMALL); float* misc = (float*)(C.ws + WS_MISC);
    const float* cw = P.in[I_CONVW] + (size_t)L * 5 * 1536; const float* cb = P.in[I_CONVB] + L * 1536;
    LAS unsigned char* BMs = C.lds; LAS unsigned char* XS = C.lds + 128 * ST128; LAS float* WG = (LAS float*)(C.lds + 128 * ST128 + 128 * ST256);
    const int hl = wave & 3, d = wave >> 2, hd = 8 * g + 4 * half + hl;
    {   float dt0, dt1, a0, a1, gt; int i0, i1; ssd_vectors(P, SMALL, tok0, L, d, hd, lane, dt0, dt1, a0, a1, gt, i0, i1);
        WG[wave * 128 + i0] = dt0 * __expf(gt - a0); WG[wave * 128 + i1] = dt1 * __expf(gt - a1);
        if (lane == 0) misc[OFF_SDEC / 4 + ((b * 2 + d) * 64 + ch) * 16 + hd] = __expf(gt); }
    stage_conv<128>(BMs, ST128, ZINb, ch * 128, ZC_XBC + 1024 + 128 * g, 1024 + 128 * g, cw, cb, tid);
    stage_conv<256>(XS, ST256, ZINb, ch * 128, ZC_XBC + 512 * g + 256 * half, 512 * g + 256 * half, cw, cb, tid);
    __syncthreads();
    bf16* SST = (bf16*)(C.ws + WS_SST) + (size_t)(((b * 2 + d) * 64 + ch) * 16 + hd) * 8192;
    for (int nh = 0; nh < 2; ++nh) {
        f32x4 acc[4][4];
#pragma unroll
        for (int a = 0; a < 4; ++a)
#pragma unroll
            for (int c = 0; c < 4; ++c) acc[a][c] = (f32x4){0.f, 0.f, 0.f, 0.f};
#pragma unroll
        for (int ks = 0; ks < 4; ++ks) {
            const f32x4 w0 = *(const LAS f32x4*)(WG + wave * 128 + 32 * ks + 8 * fq), w1 = *(const LAS f32x4*)(WG + wave * 128 + 32 * ks + 8 * fq + 4);
            bf16x8 bx[4];
#pragma unroll
            for (int pt = 0; pt < 4; ++pt) bx[pt] = frag_scale8(frag_tr(XS, ST256, 32 * ks, hl * 64 + 16 * pt, lane), w0, w1);
#pragma unroll
            for (int nt = 0; nt < 4; ++nt) { const bf16x8 a = frag_tr(BMs, ST128, 32 * ks, 64 * nh + 16 * nt, lane);
#pragma unroll
                for (int pt = 0; pt < 4; ++pt) acc[nt][pt] = mfma16(a, bx[pt], acc[nt][pt]); } }
#pragma unroll
        for (int nt = 0; nt < 4; ++nt)
#pragma unroll
            for (int pt = 0; pt < 4; ++pt) { u32x2 w; w.x = pk2(acc[nt][pt][0], acc[nt][pt][1]); w.y = pk2(acc[nt][pt][2], acc[nt][pt][3]);
                *(GAS u32x2*)(SST + (size_t)(16 * pt + fr) * 128 + 64 * nh + 16 * nt + 4 * fq) = w; }
    }
    __syncthreads();
}
DEV void ssd_scan(const Ctx& C0) {
    const Ctx C = fresh(C0);
    const float* SDEC = (const float*)(C.ws + WS_MISC) + OFF_SDEC / 4; bf16* SST = (bf16*)(C.ws + WS_SST);
    const int nthreads = C.G * 512;
    for (int t = C.bid * 512 + C.tid; t < 64 * 2048; t += nthreads) {
        const int e4 = t & 2047, hd = (t >> 11) & 15, bd = t >> 15, d = bd & 1;
        bf16* base = SST + (size_t)(bd * 64 * 16 + hd) * 8192 + e4 * 4; const size_t cst = (size_t)16 * 8192;
        f32x4 st = (f32x4){0.f, 0.f, 0.f, 0.f};
        for (int s8 = 0; s8 < 64; s8 += 16) { u32x2 x[16];
#pragma unroll
            for (int k = 0; k < 16; ++k) { const int ch = d ? 63 - (s8 + k) : s8 + k; x[k] = *(const GAS u32x2*)(base + (size_t)ch * cst); }
#pragma unroll
            for (int k = 0; k < 16; ++k) { const int ch = d ? 63 - (s8 + k) : s8 + k; const float dc = SDEC[(bd * 64 + ch) * 16 + hd];
                u32x2 w; w.x = pk2(st[0], st[1]); w.y = pk2(st[2], st[3]); *(GAS u32x2*)(base + (size_t)ch * cst) = w;
                st = st * dc + (f32x4){bflo(x[k].x), bfhi(x[k].x), bflo(x[k].y), bfhi(x[k].y)}; } }
    }
}
DEV void ssd_out_unit(const Params& P, const Ctx& C0, int L, int unit) {
    const Ctx C = fresh(C0);
    const int half = unit & 1, g = (unit >> 1) & 1, ch = (unit >> 2) & 63, b = unit >> 8, tid = C.tid, lane = C.lane, wave = C.wave, fr = lane & 15, fq = lane >> 4;
    const size_t tok0 = (size_t)b * SEQ + ch * 128;
    const bf16* ZIN = (const bf16*)(C.ws + WS_ZIN); const bf16* ZINb = ZIN + (size_t)b * SEQ * ZW; const float* SMALL = (const float*)(C.ws + WS_SMALL);
    const float* cw = P.in[I_CONVW] + (size_t)L * 5 * 1536; const float* cb = P.in[I_CONVB] + L * 1536;
    LAS unsigned char* CMs = C.lds; LAS unsigned char* BC = C.lds + 128 * ST128; LAS unsigned char* XS = C.lds + 2 * 128 * ST128;
    LAS float* DT = (LAS float*)(C.lds + 2 * 128 * ST128 + 128 * ST256); LAS float* ACS = DT + 8 * 128;
    {   const int hl = wave & 3, d = wave >> 2, hd = 8 * g + 4 * half + hl;
        float dt0, dt1, a0, a1, gt; int i0, i1; ssd_vectors(P, SMALL, tok0, L, d, hd, lane, dt0, dt1, a0, a1, gt, i0, i1);
        DT[wave * 128 + i0] = dt0; DT[wave * 128 + i1] = dt1; ACS[wave * 128 + i0] = a0; ACS[wave * 128 + i1] = a1; }
    stage_conv<128>(CMs, ST128, ZINb, ch * 128, ZC_XBC + 1280 + 128 * g, 1280 + 128 * g, cw, cb, tid);
    stage_conv<128>(BC, ST128, ZINb, ch * 128, ZC_XBC + 1024 + 128 * g, 1024 + 128 * g, cw, cb, tid);
    stage_conv<256>(XS, ST256, ZINb, ch * 128, ZC_XBC + 512 * g + 256 * half, 512 * g + 256 * half, cw, cb, tid);
    __syncthreads();
    {
        f32x4 cbr[8];
#pragma unroll
        for (int st = 0; st < 8; ++st) cbr[st] = (f32x4){0.f, 0.f, 0.f, 0.f};
#pragma unroll
        for (int ks = 0; ks < 4; ++ks) { const bf16x8 bc = frag_row(CMs, ST128, 16 * wave, 32 * ks, lane);
#pragma unroll
            for (int st = 0; st < 8; ++st) cbr[st] = mfma16(frag_row(BC, ST128, 16 * st, 32 * ks, lane), bc, cbr[st]); }
        __syncthreads();
        const int t = 16 * wave + fr;
#pragma unroll
        for (int st = 0; st < 8; ++st) { u32x2 w; w.x = pk2(cbr[st][0], cbr[st][1]); w.y = pk2(cbr[st][2], cbr[st][3]); *(LAS u32x2*)(BC + t * ST128 + (16 * st + 4 * fq) * 2) = w; }
    }
    __syncthreads();
    const int hl = wave & 3, th = wave >> 2, hd = 8 * g + 4 * half + hl;
    f32x4 acc[4][4];
#pragma unroll
    for (int a = 0; a < 4; ++a)
#pragma unroll
        for (int c = 0; c < 4; ++c) acc[a][c] = (f32x4){0.f, 0.f, 0.f, 0.f};
    for (int d = 0; d < 2; ++d) {
        const LAS float* dtv = DT + (hl + 4 * d) * 128; const LAS float* acv = ACS + (hl + 4 * d) * 128;
        const bf16* S0 = (const bf16*)(C.ws + WS_SST) + (size_t)(((b * 2 + d) * 64 + ch) * 16 + hd) * 8192;
        bf16x8 bs[4][4];
#pragma unroll
        for (int ks = 0; ks < 4; ++ks)
#pragma unroll
            for (int pt = 0; pt < 4; ++pt) bs[ks][pt] = *(const GAS bf16x8*)(S0 + (size_t)(16 * pt + fr) * 128 + 32 * ks + 8 * fq);
#pragma unroll 1
        for (int ks = 0; ks < 4; ++ks) {
            bf16x8 bx[4];
#pragma unroll
            for (int pt = 0; pt < 4; ++pt) bx[pt] = frag_tr(XS, ST256, 32 * ks, hl * 64 + 16 * pt, lane);
            const int s0 = 32 * ks + 8 * fq;
            const f32x4 as0 = *(const LAS f32x4*)(acv + s0), as1 = *(const LAS f32x4*)(acv + s0 + 4), ds0 = *(const LAS f32x4*)(dtv + s0), ds1 = *(const LAS f32x4*)(dtv + s0 + 4);
#pragma unroll
            for (int tt = 0; tt < 4; ++tt) { const int t = 64 * th + 16 * tt + fr; const float at = acv[t];
                const bf16x8 cbf = frag_row(BC, ST128, 64 * th + 16 * tt, 32 * ks, lane); f32x4 l0, l1;
#pragma unroll
                for (int e = 0; e < 4; ++e) { const int sa = s0 + e, sb = s0 + 4 + e; const bool va = d ? (sa >= t) : (sa <= t), vb = d ? (sb >= t) : (sb <= t);
                    l0[e] = va ? __expf(at - as0[e]) * ds0[e] : 0.f; l1[e] = vb ? __expf(at - as1[e]) * ds1[e] : 0.f; }
                const bf16x8 a = frag_scale8(cbf, l0, l1);
#pragma unroll
                for (int pt = 0; pt < 4; ++pt) if (!((DBG_SSD >> 0) & 1) && !((DBG_SSD >> (2 + d)) & 1)) acc[tt][pt] = mfma16(a, bx[pt], acc[tt][pt]); } }
#pragma unroll
        for (int ks = 0; ks < 4; ++ks) {
#pragma unroll
            for (int tt = 0; tt < 4; ++tt) { const int t = 64 * th + 16 * tt + fr;
                const bf16x8 a = frag_scale(frag_row(CMs, ST128, 64 * th + 16 * tt, 32 * ks, lane), __expf(acv[t]));
#pragma unroll
                for (int pt = 0; pt < 4; ++pt) if (!((DBG_SSD >> 1) & 1) && !((DBG_SSD >> (2 + d)) & 1)) acc[tt][pt] = mfma16(a, bs[ks][pt], acc[tt][pt]);
                __builtin_amdgcn_sched_barrier(0); } }
    }
    __syncthreads();
    LAS unsigned char* YT = C.lds;
#pragma unroll
    for (int tt = 0; tt < 4; ++tt)
#pragma unroll
        for (int i = 0; i < 4; ++i) { const int t = 64 * th + 16 * tt + 4 * fq + i;
#pragma unroll
            for (int pt = 0; pt < 4; ++pt) *(LAS unsigned short*)(YT + t * ST256 + (hl * 64 + 16 * pt + fr) * 2) = (unsigned short)f2bf(acc[tt][pt][i]); }
    __syncthreads();
    {   bf16* YB = (bf16*)(C.ws + WS_Y) + (size_t)M * 1024; u64* ybss = (u64*)(C.ws + OFF_YBSS) + (size_t)L * M; const int ch0 = 512 * g + 256 * half;
        u32x4 zq[8];
#pragma unroll
        for (int k = 0; k < 8; ++k) { const int c = tid + 512 * k, t = c >> 5, c8 = (c & 31) * 8; zq[k] = *(const GAS u32x4*)(ZIN + (tok0 + t) * ZW + ZC_BZ + ch0 + c8); }
#pragma unroll
        for (int k = 0; k < 8; ++k) { const int c = tid + 512 * k, t = c >> 5, c8 = (c & 31) * 8; float yv[8], xv[8], zv[8], o[8];
            const float dsk = P.in[I_SSD][L * 16 + 8 * g + 4 * half + (c8 >> 6)];
            unpack8(*(const LAS u32x4*)(YT + t * ST256 + c8 * 2), yv); unpack8(*(const LAS u32x4*)(XS + t * ST256 + c8 * 2), xv); unpack8(zq[k], zv);
            float part = 0.f;
#pragma unroll
            for (int e = 0; e < 8; ++e) { o[e] = (yv[e] + dsk * xv[e]) * siluf_(zv[e]); part += o[e] * o[e]; }
            *(GAS u32x4*)(YB + (tok0 + t) * 1024 + ch0 + c8) = pack8(o);
            part += shx(part, 1, lane); part += shx(part, 2, lane); part += shx(part, 4, lane); part += shx(part, 8, lane); part += shx(part, 16, lane);
            if ((lane & 31) == 0) ss_add(ybss + tok0 + t, part); }
    }
    __syncthreads();
}

DEV void krope_phase(const Ctx& C0) {
    const Ctx C = fresh(C0);
    const float* SMALL = (const float*)(C.ws + WS_SMALL); const float* COS = (const float*)(C.ws + WS_COS); const float* SIN = (const float*)(C.ws + WS_SIN); bf16* KR = (bf16*)(C.ws + WS_KR);
    for (int i = C.bid * 512 + C.tid; i < M * 32; i += C.G * 512) { const int m = i >> 5, j = i & 31;
        const float t1 = SMALL[(size_t)m * SMW + 48 + j], t2 = SMALL[(size_t)m * SMW + 80 + j], cs = COS[i], sn = SIN[i];
        KR[(size_t)m * 64 + j] = (bf16)f2bf(t1 * cs - t2 * sn); KR[(size_t)m * 64 + 32 + j] = (bf16)f2bf(t2 * cs + t1 * sn); }
}
DEV void final_phase(const Params& P, const Ctx& C0) {
    const Ctx C = fresh(C0);
    const bf16* HB = (const bf16*)(C.ws + WS_HB0); const u64* hss = (const u64*)(C.ws + OFF_HSS) + (size_t)16 * M; const float* gn = P.in[I_FIN];
    for (size_t i = (size_t)C.bid * 512 + C.tid; i < (size_t)M * DM / 8; i += (size_t)C.G * 512) { const int m = (int)(i >> 8), c = (int)(i & 255) * 8;
        const float rs = ss_to_rstd(hss[m], 1.f / DM); float h[8]; unpack8(*(const GAS u32x4*)(HB + i * 8), h);
        const f32x4 g0 = *(const f32x4*)(gn + c), g1 = *(const f32x4*)(gn + c + 4);
        *(GAS f32x4*)(P.out + i * 8) = (f32x4){h[0] * rs * g0[0], h[1] * rs * g0[1], h[2] * rs * g0[2], h[3] * rs * g0[3]};
        *(GAS f32x4*)(P.out + i * 8 + 4) = (f32x4){h[4] * rs * g1[0], h[5] * rs * g1[1], h[6] * rs * g1[2], h[7] * rs * g1[3]}; }
}
#ifndef MK_MODE
#define MK_MODE 0
#endif
constexpr int NPHASE = 12;

__global__ void __launch_bounds__(512, 2) mk_fwd(Params P) {
    extern __shared__ __attribute__((aligned(16))) unsigned char lds[];
    Ctx CK; CK.lds = (LAS unsigned char*)lds; CK.ws = P.ws; CK.tid = threadIdx.x; CK.lane = CK.tid & 63; CK.wave = __builtin_amdgcn_readfirstlane(CK.tid >> 6); CK.G = gridDim.x; CK.bid = blockIdx.x;
    volatile LAS unsigned* MISC = (volatile LAS unsigned*)(CK.lds + LDS_MISC);
    if (CK.tid < 64) MISC[CK.tid] = 0u;
    __syncthreads();
    XcdBarrier bar; bar.bar = (unsigned*)(P.ws + WS_CTL) + CW_BAR; bar.x = 0; bar.st = nullptr;
    if (P.use_bar) bar = xcd_barrier_post((unsigned*)(P.ws + WS_CTL) + CW_BAR, MISC + 8);
#define SEAM() do { if (P.use_bar) xcd_barrier(bar); } while (0)
#ifndef MK_DUP
#define MK_DUP 0
#endif
#define REP(k) for (int rep_ = 0; rep_ < (((MK_DUP >> (k)) & 1) ? 2 : 1); ++rep_)
#ifndef MK_SUB
#define MK_SUB 0xFFFF
#endif
#define SUB(k) ((MK_SUB >> (k)) & 1)
#ifndef MK_MASK
#define MK_MASK 0xFFFF
#endif
#define IN(k) (((MK_MASK >> (k)) & 1) && P.ph_lo <= (k) && (k) < P.ph_hi)
#define WSP(T, off) ((T*)(C.ws + (off)))
#define WB WSP(bf16, WS_W)
#define H WSP(float, WS_H)
#define HB0 WSP(bf16, WS_HB0)
#define HB1 WSP(bf16, WS_HB1)
#define ZIN WSP(bf16, WS_ZIN)
#define U WSP(bf16, WS_U)
#define SMALL WSP(float, WS_SMALL)
#define Q WSP(bf16, WS_Q)
#define KN WSP(bf16, WS_KN)
#define V WSP(bf16, WS_V)
#define KR WSP(bf16, WS_KR)
#define PP WSP(bf16, WS_PP)
#define PB WSP(bf16, WS_PB)
#define COS WSP(float, WS_COS)
#define SIN WSP(float, WS_SIN)
#define MERGE WSP(float, WS_MERGE)
#define MERGEB WSP(bf16, WS_MERGEB)
#define Y WSP(bf16, WS_Y)
#define HSS WSP(u64, OFF_HSS)
#define CQSS WSP(u64, OFF_CQSS)
#define CKVSS WSP(u64, OFF_CKVSS)
#define YBSS WSP(u64, OFF_YBSS)
    if (P.l_lo == 0 && P.l_hi > 0 && IN(0)) rope_tables(P, CK);
    for (int L = P.l_lo; L < P.l_hi; ++L) {
        if (IN(0)) REP(0) { const Ctx C = fresh(CK); phase_convert(P, C, L); SEAM(); }
        if (IN(1)) REP(1) { const Ctx C = fresh(CK);
            pg8::Gemm g{HB0, WB + WE_13A, DM, DM, DM}; pg8::StaticOrder S; S.init(M, 2 * FF, C.G, C.bid);
            EpiSwiGLU E{HSS + (size_t)(4 * L) * M, U};
            pg8::gemm_phase<EpiSwiGLU, pg8::StaticOrder, true>(C.lds, g, S, E, C.tid); SEAM(); }
        if (IN(2)) { const Ctx C = fresh(CK);
            pg8::Gemm g{U, WB + WE_2A, FF, FF, FF}; pg8::StaticOrder S; S.init(M, DM, C.G, C.bid);
            EpiResid<0> E{HB0, HB1, HSS + (size_t)(4 * L + 1) * M, 0.5f, nullptr, nullptr};
            pg8::gemm_phase<EpiResid<0>, pg8::StaticOrder, true>(C.lds, g, S, E, C.tid); SEAM(); }
        if (IN(3)) { const Ctx C = fresh(CK);
            pg8::Gemm g{HB1, WB + WE_IN, DM, DM, DM}; pg8::StaticOrder S; S.init(M, WIN_ROWS, C.G, C.bid);
            EpiWin E{HSS + (size_t)(4 * L + 1) * M, ZIN, SMALL, CQSS + (size_t)L * M, CKVSS + (size_t)L * M};
            pg8::gemm_phase<EpiWin, pg8::StaticOrder, true>(C.lds, g, S, E, C.tid); SEAM(); }
        if (IN(4)) REP(4) { const Ctx C = fresh(CK);
            if (SUB(2)) { pg8::Gemm g{ZIN + ZC_CQ, WB + WE_UQ, ZW, 512, 512}; pg8::StaticOrder S; S.init(M, 1536, C.G, C.bid);
              EpiQup E{CQSS + (size_t)L * M, Q, COS, SIN}; pg8::gemm_phase<EpiQup, pg8::StaticOrder, true>(C.lds, g, S, E, C.tid); }
            if (SUB(3)) { pg8::Gemm g{ZIN + ZC_CKV, WB + WE_UKV, ZW, 512, 512}; pg8::StaticOrder S; S.init(M, 2048, C.G, C.bid);
              EpiKVup E{CKVSS + (size_t)L * M, KN, V}; pg8::gemm_phase<EpiKVup, pg8::StaticOrder, true>(C.lds, g, S, E, C.tid); }
            krope_phase(C);
            if (SUB(0)) for (int u = C.bid; u < 512; u += C.G) mlstm_state_unit(P, C, L, u);
            if (SUB(1)) for (int u = C.bid; u < 512; u += C.G) ssd_state_unit(P, C, L, u);
            SEAM(); }
        if (IN(5)) { const Ctx C = fresh(CK);
            if (SUB(7)) { mlstm_scan(C); ssd_scan(C); }
            if (SUB(6)) REP(13) for (int i = 0; i < 512; i += C.G) { int bh, qb;
                if (C.G == 256) { bh = (C.bid & 7) + 8 * (i >> 8); qb = C.bid >> 3; } else { const int u = i + C.bid; if (u >= 512) break; bh = u >> 5; qb = u & 31; }
                const int b = bh >> 3, h = bh & 7;
                att::attn_unit(Q + ((size_t)bh * SEQ + qb * 256) * 192, KN + (size_t)bh * SEQ * 128, V + (size_t)bh * SEQ * 128, KR + (size_t)b * SEQ * 64,
                               Y + (size_t)2 * M * 1024 + ((size_t)b * SEQ + qb * 256) * 1024 + h * 128, SEQ, (char*)lds, CK.lds, fresh(CK).tid); }
            SEAM(); }
        if (IN(6)) { const Ctx C = fresh(CK);
            if (SUB(4)) REP(14) for (int u = C.bid; u < 512; u += C.G) mlstm_out_unit(P, C, L, u);
            if (SUB(5)) for (int u = C.bid; u < 512; u += C.G) ssd_out_unit(P, C, L, u);
            SEAM(); }
        if (IN(7)) REP(7) { const Ctx C = fresh(CK);
            if (SUB(8)) { pg8::Gemm g{Y, WB + WE_BR, 1024, 1024, 1024}; pg8::BranchOrder S{C.G, C.bid};
              EpiBranch E{ZIN, YBSS + (size_t)L * M, MERGEB}; pg8::gemm_phase<EpiBranch, pg8::BranchOrder, true>(C.lds, g, S, E, C.tid); }
            if (SUB(9)) { pg8::Gemm g{PB, WB + WE_PP, PLE, PLE, PLE}; pg8::StaticOrder S; S.init(M, DM, C.G, C.bid);
              EpiPlain E{PP, DM}; pg8::gemm_phase<EpiPlain, pg8::StaticOrder, true>(C.lds, g, S, E, C.tid); }
            SEAM(); }
        if (IN(8)) { const Ctx C = fresh(CK);
            pg8::Gemm g{MERGEB, WB + WE_OUT, DM, DM, DM}; pg8::StaticOrder S; S.init(M, DM, C.G, C.bid);
            EpiResid<0> E{HB1, HB0, HSS + (size_t)(4 * L + 2) * M, 1.0f, nullptr, nullptr};
            pg8::gemm_phase<EpiResid<0>, pg8::StaticOrder, true>(C.lds, g, S, E, C.tid); SEAM(); }
        if (IN(9)) { const Ctx C = fresh(CK);
            pg8::Gemm g{HB0, WB + WE_13B, DM, DM, DM}; pg8::StaticOrder S; S.init(M, 2 * FF, C.G, C.bid);
            EpiSwiGLU E{HSS + (size_t)(4 * L + 2) * M, U};
            pg8::gemm_phase<EpiSwiGLU, pg8::StaticOrder, true>(C.lds, g, S, E, C.tid); SEAM(); }
        if (IN(10)) { const Ctx C = fresh(CK);
            pg8::Gemm g{U, WB + WE_2B, FF, FF, FF}; pg8::StaticOrder S; S.init(M, DM, C.G, C.bid);
            EpiResid<0> E{HB0, HB1, HSS + (size_t)(4 * L + 3) * M, 0.5f, nullptr, nullptr};
            pg8::gemm_phase<EpiResid<0>, pg8::StaticOrder, true>(C.lds, g, S, E, C.tid); SEAM(); }
        if (IN(11)) { const Ctx C = fresh(CK);
            pg8::Gemm g{HB1, WB + WE_PG, DM, DM, DM}; pg8::StaticOrder S; S.init(M, DM, C.G, C.bid);
            EpiResid<1> E{HB1, HB0, HSS + (size_t)(4 * L + 4) * M, 0.f, HSS + (size_t)(4 * L + 3) * M, PP};
            pg8::gemm_phase<EpiResid<1>, pg8::StaticOrder, true>(C.lds, g, S, E, C.tid); SEAM(); }
    }
    if (((MK_MASK >> 12) & 1) && P.l_hi == DEPTH && P.ph_hi > NPHASE) final_phase(P, CK);
#undef SEAM
#undef IN
#undef WSP
#undef WB
#undef H
#undef HB0
#undef HB1
#undef ZIN
#undef U
#undef SMALL
#undef Q
#undef KN
#undef V
#undef KR
#undef PP
#undef PB
#undef COS
#undef SIN
#undef MERGE
#undef MERGEB
#undef Y
#undef HSS
#undef CQSS
#undef CKVSS
#undef YBSS
}

extern "C" void kernel_launch(void* const* d_in, const int* in_sizes, int n_in, void* d_out, int out_size, void* d_ws, size_t ws_size, hipStream_t stream) {
    static int grid = 0;
    if (grid == 0) {
        if (n_in != 30 || in_sizes[0] != M * DM || out_size != M * DM || ws_size < WS_END) {
            fprintf(stderr, "kernel_launch: unexpected shapes: n_in %d in0 %d out %d ws %zu (need %zu)\n", n_in, n_in > 0 ? in_sizes[0] : -1, out_size, ws_size, (size_t)WS_END); grid = -1; return; }
        int dev = 0, cus = 0, per_cu = 0;
        if (hipGetDevice(&dev) != hipSuccess || hipDeviceGetAttribute(&cus, hipDeviceAttributeMultiprocessorCount, dev) != hipSuccess) { grid = -1; return; }
        if (hipFuncSetAttribute((const void*)mk_fwd, hipFuncAttributeMaxDynamicSharedMemorySize, LDS_BYTES) != hipSuccess) { fprintf(stderr, "kernel_launch: hipFuncSetAttribute failed\n"); grid = -1; return; }
        if (hipOccupancyMaxActiveBlocksPerMultiprocessor(&per_cu, (const void*)mk_fwd, 512, LDS_BYTES) != hipSuccess || per_cu < 1)
            fprintf(stderr, "kernel_launch: note: occupancy query reports %d workgroups per CU\n", per_cu);
        (void)hipGetLastError();
        grid = cus;
    }
    if (grid < 0) return;
    if (hipMemsetAsync((char*)d_ws + WS_CTL, 0, CTL_ZERO_BYTES, stream) != hipSuccess) return;
    Params p; memset(&p, 0, sizeof(p));
    for (int i = 0; i < 30; ++i) p.in[i] = (const float*)d_in[i];
    p.out = (float*)d_out; p.ws = (unsigned char*)d_ws;
#if MK_MODE == 0
    p.l_lo = 0; p.l_hi = DEPTH; p.ph_lo = 0; p.ph_hi = NPHASE + 1; p.use_bar = 1;
    hipLaunchKernelGGL(mk_fwd, dim3(grid), dim3(512), LDS_BYTES, stream, p);
#else
    p.use_bar = 0;
    for (int L = 0; L < DEPTH; ++L)
        for (int k = 0; k < NPHASE; ++k) { p.l_lo = L; p.l_hi = L + 1; p.ph_lo = k; p.ph_hi = k + 1;
            hipLaunchKernelGGL(mk_fwd, dim3(grid), dim3(512), LDS_BYTES, stream, p); }
    p.l_lo = DEPTH; p.l_hi = DEPTH; p.ph_lo = NPHASE; p.ph_hi = NPHASE + 1;
    hipLaunchKernelGGL(mk_fwd, dim3(grid), dim3(512), LDS_BYTES, stream, p);
#endif
    const hipError_t le = hipPeekAtLastError();
    if (le != hipSuccess) fprintf(stderr, "kernel_launch: launch failed: %s\n", hipGetErrorName(le));
}
```

```cpp
#include <hip/hip_runtime.h>
#include <cstdio>
#include <cstdint>
#include <cstring>

#define DEV __device__ __forceinline__
#define LAS __attribute__((address_space(3)))
#define GAS __attribute__((address_space(1)))
typedef unsigned short bf16;
typedef unsigned long long u64;
typedef short bf16x8 __attribute__((ext_vector_type(8)));
typedef short s16x4 __attribute__((ext_vector_type(4)));
typedef float f32x4 __attribute__((ext_vector_type(4)));
typedef float f32x16 __attribute__((ext_vector_type(16)));
typedef unsigned u32x4 __attribute__((ext_vector_type(4)));
typedef unsigned u32x2 __attribute__((ext_vector_type(2)));

namespace pg8 {
#define PG8_LAS __attribute__((address_space(3)))
typedef unsigned short bf16_t;
constexpr int BM = 256, BK = 64, HALF = 128, HTB = HALF * BK * 2, STAGE_BYTES = 8 * HTB, NXCD = 8, WGM = 4;

__host__ __device__ __forceinline__ int lds_byte(int r, int c) { const int st = (r >> 4) * 2 + (c >> 5), rr = r & 15, cc = c & 31, ob = rr * 64 + cc * 2; return st * 1024 + (ob ^ (((ob >> 9) & 1) << 5)); }
__host__ __device__ __forceinline__ void stage_rc(int b, int& R, int& C) { const int st = b / 1024, sb = b % 1024, swz = sb ^ (((sb >> 9) & 1) << 5); R = (st >> 1) * 16 + swz / 64; C = (st & 1) * 32 + (swz % 64) / 2; }
__host__ __device__ __forceinline__ int perm32(int rho) { const int n = rho >> 4, i = rho & 15; return 8 * (i >> 2) + 4 * n + (i & 3); }

struct Unit { int pm, pn; };
struct Gemm { const bf16_t* A; const bf16_t* Bt; int lda, ldb, K; };

struct StaticOrder {
    int nM, nN, nwg, G, c;
    __host__ __device__ void init(int M, int N, int G_, int c_) { nM = M / BM; nN = N / BM; nwg = nM * nN; G = G_; c = c_; }
    __host__ __device__ bool next(int i, Unit& u) const {
        const long L = (long)i * G + c; if (L >= nwg) return false;
        int wgid = (int)L; { const int q = nwg / NXCD, r = nwg % NXCD, xcd = wgid % NXCD, off = wgid / NXCD; wgid = (xcd < r ? xcd * (q + 1) : r * (q + 1) + (xcd - r) * q) + off; }
        const int nig = WGM * nN, gid = wgid / nig, fm = gid * WGM, gsz = (nM - fm) < WGM ? (nM - fm) : WGM;
        u.pm = fm + ((wgid % nig) % gsz); u.pn = (wgid % nig) / gsz; return true;
    }
};
struct BranchOrder {
    int G, c;
    __host__ __device__ bool next(int i, Unit& u) const {
        StaticOrder S; S.init(16384, 2048, G, c); Unit t; if (!S.next(i / 3, t)) return false;
        const int j = i % 3; u.pm = j * 64 + t.pm; u.pn = j * 8 + t.pn; return true;
    }
};

constexpr int PRE_OFF = STAGE_BYTES;
template <class Epi, class Sched, bool ALIGN_EPI>
__device__ __forceinline__ void gemm_phase(PG8_LAS unsigned char* lds, const Gemm g, const Sched& S, const Epi& E, int tid_in) {
    int tid_ = tid_in; asm volatile("" : "+v"(tid_));
    const int tid = tid_, wid = __builtin_amdgcn_readfirstlane(tid >> 6), lane = tid & 63, wr = wid >> 2, wc = wid & 3, fr = lane & 15, fq = lane >> 4;
    const int K = g.K, nt = K / BK;
    unsigned voffA[2], voffB[2];
#pragma unroll
    for (int i = 0; i < 2; ++i) { int R, C; stage_rc(tid * 16 + i * 8192, R, C); const int Rb = (R & ~31) + perm32(R & 31);
        voffA[i] = (unsigned)(R * g.lda + C) * 2u; voffB[i] = (unsigned)(Rb * g.ldb + C) * 2u; }
    const size_t kstep = (size_t)(BK * 2);
    const size_t hstepA = (size_t)HALF * g.lda * 2, hstepB = (size_t)HALF * g.ldb * 2;
    const size_t tstepA = 2 * hstepA, tstepB = 2 * hstepB;
    const unsigned ldsw = (unsigned)wid * 1024u;
    const int aoff = lds_byte(wr * 64 + fr, fq * 8), boff = lds_byte(wc * 32 + fr, fq * 8);
#define PG8_SA(b, h) (((b) * 2 + (h)) * HTB)
#define PG8_SB(b, h) ((4 + (b) * 2 + (h)) * HTB)
#define PG8_STAGE(bufoff, gbase, voff) do { _Pragma("unroll") for (int _i = 0; _i < 2; ++_i) \
        __builtin_amdgcn_global_load_lds((const unsigned*)((const char*)(gbase) + (voff)[_i]), (PG8_LAS unsigned*)(lds + (bufoff) + ldsw + _i * 8192), 16, 0, 0); } while (0)
#define PG8_LDA(dst, b, h) do { _Pragma("unroll") for (int m = 0; m < 4; ++m) _Pragma("unroll") for (int k = 0; k < 2; ++k) dst[m][k] = *(const PG8_LAS bf16x8*)(lds + PG8_SA(b, h) + aoff + m * 2048 + k * 1024); } while (0)
#define PG8_LDB(dst, b, h) do { _Pragma("unroll") for (int n = 0; n < 2; ++n) _Pragma("unroll") for (int k = 0; k < 2; ++k) dst[n][k] = *(const PG8_LAS bf16x8*)(lds + PG8_SB(b, h) + boff + n * 2048 + k * 1024); } while (0)
#define PG8_MMA(ai, bj, At, Bt) do { __builtin_amdgcn_s_setprio(1); _Pragma("unroll") for (int m = 0; m < 4; ++m) _Pragma("unroll") for (int n = 0; n < 2; ++n) _Pragma("unroll") for (int k = 0; k < 2; ++k) \
        acc[ai][bj][m][n] = __builtin_amdgcn_mfma_f32_16x16x32_bf16(Bt[n][k], At[m][k], acc[ai][bj][m][n], 0, 0, 0); __builtin_amdgcn_s_setprio(0); } while (0)
#define PG8_WAIT_V(n) asm volatile("s_waitcnt vmcnt(" #n ")" ::: "memory")
#define PG8_WAIT_L(n) asm volatile("s_waitcnt lgkmcnt(" #n ")" ::: "memory")
#define PG8_BAR __builtin_amdgcn_s_barrier()
#define PG8_SCHED __builtin_amdgcn_sched_barrier(0)
    Unit cur, nxt; int ui = 0;
    if (!S.next(0, cur)) return;
    PG8_LAS unsigned long long* const pre = (PG8_LAS unsigned long long*)(lds + PRE_OFF + wid * 1024);
#define PG8_PRE(u) do { if constexpr (Epi::PRE) { int ln_ = lane; asm volatile("" : "+v"(ln_));     \
        const int prerow = wr * 64 + ((ln_ >> 5) & 1) * 128 + ((ln_ >> 3) & 3) * 16 + 2 * (ln_ & 7); \
        __builtin_amdgcn_global_load_lds((const unsigned*)(E.pre_ptr() + (u).pm * 256 + prerow), (PG8_LAS unsigned*)pre, 16, 0, 0); } } while (0)
    PG8_PRE(cur);
    f32x4 acc[2][2][4][2];
#pragma unroll
    for (int a = 0; a < 2; ++a)
#pragma unroll
        for (int b = 0; b < 2; ++b)
#pragma unroll
            for (int m = 0; m < 4; ++m)
#pragma unroll
                for (int n = 0; n < 2; ++n) acc[a][b][m][n] = (f32x4){0.f, 0.f, 0.f, 0.f};
    bf16x8 At[4][2], B0[2][2], B1[2][2];
    const char* cA = (const char*)g.A + (size_t)cur.pm * tstepA; const char* cB = (const char*)g.Bt + (size_t)cur.pn * tstepB;
    PG8_STAGE(PG8_SB(0, 0), cB, voffB); PG8_STAGE(PG8_SB(0, 1), cB + hstepB, voffB); PG8_STAGE(PG8_SA(0, 0), cA, voffA); PG8_STAGE(PG8_SA(0, 1), cA + hstepA, voffA);
    if (wr == 1) PG8_BAR;
    PG8_WAIT_V(2); PG8_BAR;
    PG8_STAGE(PG8_SB(1, 0), cB + kstep, voffB); PG8_STAGE(PG8_SA(1, 0), cA + kstep, voffA); PG8_STAGE(PG8_SB(1, 1), cB + hstepB + kstep, voffB);
    PG8_WAIT_V(6); PG8_BAR;
    for (;;) {
        const bool has_next = S.next(ui + 1, nxt);
        const char* nA = has_next ? (const char*)g.A + (size_t)nxt.pm * tstepA : cA; const char* nB = has_next ? (const char*)g.Bt + (size_t)nxt.pn * tstepB : cB;
#pragma unroll 1
        for (int t = 0; t < nt; t += 2) {
            const bool last = (t == nt - 2);
            const char* a1 = cA + (size_t)(t + 1) * kstep;
            const char* a2 = last ? nA : cA + (size_t)(t + 2) * kstep; const char* b2 = last ? nB : cB + (size_t)(t + 2) * kstep;
            const char* a3 = a2 + kstep; const char* b3 = b2 + kstep;
            PG8_LDB(B0, 0, 0); PG8_LDB(B1, 0, 1); PG8_SCHED; PG8_LDA(At, 0, 0); PG8_STAGE(PG8_SA(1, 1), a1 + hstepA, voffA);
            PG8_WAIT_V(8); PG8_WAIT_L(0); PG8_BAR; PG8_MMA(0, 0, At, B0); PG8_MMA(0, 1, At, B1); PG8_BAR; PG8_SCHED;
            PG8_LDA(At, 0, 1); PG8_STAGE(PG8_SB(0, 0), b2, voffB); PG8_STAGE(PG8_SB(0, 1), b2 + hstepB, voffB); PG8_STAGE(PG8_SA(0, 0), a2, voffA);
            PG8_WAIT_V(8); PG8_WAIT_L(0); PG8_BAR; PG8_MMA(1, 0, At, B0); PG8_MMA(1, 1, At, B1); PG8_BAR; PG8_SCHED;
            PG8_LDB(B0, 1, 0); PG8_LDB(B1, 1, 1); PG8_SCHED; PG8_LDA(At, 1, 0); PG8_STAGE(PG8_SA(0, 1), a2 + hstepA, voffA);
            PG8_WAIT_V(8); PG8_WAIT_L(0); PG8_BAR; PG8_MMA(0, 0, At, B0); PG8_MMA(0, 1, At, B1); PG8_BAR; PG8_SCHED;
            PG8_LDA(At, 1, 1); PG8_STAGE(PG8_SB(1, 0), b3, voffB); PG8_STAGE(PG8_SB(1, 1), b3 + hstepB, voffB); PG8_STAGE(PG8_SA(1, 0), a3, voffA);
            PG8_WAIT_V(8); PG8_WAIT_L(0); PG8_BAR; PG8_MMA(1, 0, At, B0); PG8_MMA(1, 1, At, B1); PG8_BAR; PG8_SCHED;
        }
        if constexpr (ALIGN_EPI) { if (wr == 0) PG8_BAR; }
        E(acc, cur, wr, wc, fr, fq, pre);
        if (!has_next) break;
        if constexpr (Epi::PRE) { PG8_WAIT_L(0); PG8_PRE(nxt); }
#pragma unroll
        for (int a = 0; a < 2; ++a)
#pragma unroll
            for (int b = 0; b < 2; ++b)
#pragma unroll
                for (int m = 0; m < 4; ++m)
#pragma unroll
                    for (int n = 0; n < 2; ++n) acc[a][b][m][n] = (f32x4){0.f, 0.f, 0.f, 0.f};
        cur = nxt; cA = nA; cB = nB; ++ui;
        if constexpr (ALIGN_EPI) { if (wr == 1) PG8_BAR; }
    }
    PG8_WAIT_V(0);
    if constexpr (!ALIGN_EPI) { if (wr == 0) PG8_BAR; }
    PG8_BAR;
#undef PG8_PRE
#undef PG8_SA
#undef PG8_SB
#undef PG8_STAGE
#undef PG8_LDA
#undef PG8_LDB
#undef PG8_MMA
#undef PG8_WAIT_V
#undef PG8_WAIT_L
#undef PG8_BAR
#undef PG8_SCHED
}
}

#define XB_TMO      128
#define XB_XCNT(j)  (256  + 64 * (j))
#define XB_XSUB(j)  (1280 + 64 * (j))
#define XB_XGEN(j)  (2304 + 64 * (j))
#define XB_TOP      3328
#define XB_TOPGEN   3392
#define XCD_BAR_WORDS 3456
#define XB_SPIN_CAP (1u << 18)

__device__ __forceinline__ unsigned xb_ld(unsigned* p)              { return __hip_atomic_load(p, __ATOMIC_RELAXED, __HIP_MEMORY_SCOPE_AGENT); }
__device__ __forceinline__ unsigned xb_add(unsigned* p, unsigned v) { return __hip_atomic_fetch_add(p, v, __ATOMIC_RELAXED, __HIP_MEMORY_SCOPE_AGENT); }
__device__ __forceinline__ unsigned xb_xcc_id() { return (unsigned)__builtin_amdgcn_s_getreg((3 << 11) | 20) & 0xFu; }
#define XB_SPIN(cond, bar) do { unsigned _sp = 0; while (cond) { __builtin_amdgcn_s_sleep(1); \
    if ((++_sp & 255u) == 0u) { if (xb_ld(&(bar)[XB_TMO])) break; if (_sp > XB_SPIN_CAP) { atomicAdd(&(bar)[XB_TMO], 1u); break; } } } } while (0)

struct XcdBarrier { unsigned* bar; unsigned x; volatile LAS unsigned* st; };

__device__ __forceinline__ XcdBarrier xcd_barrier_post(unsigned* bar, volatile LAS unsigned* st) {
    XcdBarrier b; b.bar = bar; b.x = xb_xcc_id(); b.st = st;
    if (threadIdx.x == 0) (void)xb_add(&bar[XB_XCNT(b.x)], 1u);
    return b;
}
__device__ __forceinline__ void xcd_barrier_complete(unsigned* bar, unsigned x, unsigned& nloc, unsigned& nx) {
    const unsigned G = gridDim.x * gridDim.y * gridDim.z;
    unsigned sum, cnt, mine, sp = 0u;
    for (;;) {
        sum = 0u; cnt = 0u; mine = 0u;
#pragma unroll
        for (unsigned j = 0; j < 16; ++j) { const unsigned c = xb_ld(&bar[XB_XCNT(j)]); sum += c; cnt += (c > 0u) ? 1u : 0u; mine = (j == x) ? c : mine; }
        if (sum == G) break;
        __builtin_amdgcn_s_sleep(1);
        if ((++sp & 255u) == 0u) { if (xb_ld(&bar[XB_TMO])) break; if (sp > XB_SPIN_CAP) { atomicAdd(&bar[XB_TMO], 1u); break; } }
    }
    nloc = mine > 0u ? mine : 1u; nx = cnt > 0u ? cnt : 1u;
}
__device__ __forceinline__ void xcd_barrier(const XcdBarrier& b) {
    asm volatile("s_waitcnt vmcnt(0)" ::: "memory");
    __syncthreads();
    if (threadIdx.x == 0) {
        unsigned* bar = b.bar;
        __builtin_amdgcn_s_waitcnt(0);
        unsigned nloc = b.st[0], nx = b.st[1];
        if (nloc == 0u) { xcd_barrier_complete(bar, b.x, nloc, nx); b.st[0] = nloc; b.st[1] = nx; }
        const unsigned old = xb_add(&bar[XB_XSUB(b.x)], 1u);
        const unsigned gen = old / nloc;
        if (old + 1u == (gen + 1u) * nloc) {
            __builtin_amdgcn_fence(__ATOMIC_RELEASE, "agent");
            asm volatile("s_waitcnt vmcnt(0)" ::: "memory");
            const unsigned og = xb_add(&bar[XB_TOP], 1u);
            const unsigned tg = og / nx;
            if (og + 1u == (tg + 1u) * nx) xb_add(&bar[XB_TOPGEN], 1u);
            else XB_SPIN(xb_ld(&bar[XB_TOPGEN]) == tg, bar);
            __builtin_amdgcn_fence(__ATOMIC_ACQUIRE, "agent");
            xb_add(&bar[XB_XGEN(b.x)], 1u);
            asm volatile("s_waitcnt vmcnt(0)" ::: "memory");
        } else {
            XB_SPIN(xb_ld(&bar[XB_XGEN(b.x)]) == gen, bar);
            __builtin_amdgcn_fence(__ATOMIC_ACQUIRE, "agent");
            asm volatile("s_waitcnt vmcnt(0)" ::: "memory");
        }
    }
    __syncthreads();
}
constexpr int NB = 2, SEQ = 8192, M = NB * SEQ, DM = 2048, FF = 5632, DEPTH = 4, PLE = 256;
constexpr int DIN_SRC = 12912, ZW = 12800, WIN_ROWS = 13056;
constexpr int ZC_AQ = 0, ZC_AK = 512, ZC_AV = 1024, ZC_AO = 2048, ZC_BZ = 3072, ZC_XBC = 4096, ZC_CQ = 5632, ZC_CKV = 6144, ZC_GATE = 6656;
constexpr int SMW = 128;
constexpr float EPS = 1e-6f;
constexpr size_t MiB = 1u << 20;
constexpr size_t WS_CTL = 0, CTL_ZERO_BYTES = 8 * MiB;
constexpr int CW_BAR = 4096;
constexpr size_t OFF_HSS = 1 * MiB;
constexpr size_t OFF_CQSS = OFF_HSS + (size_t)17 * M * 8;
constexpr size_t OFF_CKVSS = OFF_CQSS + (size_t)4 * M * 8;
constexpr size_t OFF_YBSS = OFF_CKVSS + (size_t)4 * M * 8;
static_assert(OFF_YBSS + (size_t)4 * M * 8 <= CTL_ZERO_BYTES, "ctl");
constexpr size_t WS_W = 8 * MiB;
constexpr size_t WE_13A = 0, WE_2A = WE_13A + (size_t)2 * FF * DM, WE_IN = WE_2A + (size_t)DM * FF, WE_UQ = WE_IN + (size_t)WIN_ROWS * DM,
                 WE_UKV = WE_UQ + (size_t)1536 * 512, WE_BR = WE_UKV + (size_t)2048 * 512, WE_OUT = WE_BR + (size_t)3 * DM * 1024,
                 WE_13B = WE_OUT + (size_t)DM * DM, WE_2B = WE_13B + (size_t)2 * FF * DM, WE_PG = WE_2B + (size_t)DM * FF, WE_PP = WE_PG + (size_t)DM * DM,
                 WE_END = WE_PP + (size_t)DM * PLE;
static_assert(WE_END * 2 <= 216 * MiB, "weights");
constexpr size_t WS_H = 224 * MiB;
constexpr size_t WS_HB0 = 352 * MiB, WS_HB1 = 416 * MiB;
constexpr size_t WS_ZIN = 480 * MiB;
constexpr size_t WS_U = WS_ZIN;
constexpr size_t WS_SMALL = 880 * MiB;
constexpr size_t WS_Q = 888 * MiB;
constexpr size_t WS_KN = 936 * MiB;
constexpr size_t WS_V = 968 * MiB;
constexpr size_t WS_PP = WS_Q;
constexpr size_t WS_KR = 1000 * MiB;
constexpr size_t WS_COS = 1002 * MiB, WS_SIN = 1004 * MiB;
constexpr size_t WS_PB = 1006 * MiB;
constexpr size_t WS_MISC = 1014 * MiB;
constexpr size_t OFF_MLOC = 0, OFF_MG = 4096, OFF_M0 = 8192, OFF_NLOC = 16384  , OFF_SDEC = OFF_NLOC + 1024 * 128 * 4  ;
constexpr size_t WS_CLOC = 1016 * MiB;
constexpr size_t WS_MERGE = WS_CLOC;
constexpr size_t WS_SST = 1144 * MiB;
constexpr size_t WS_MERGEB = WS_SST;
constexpr size_t WS_Y = 1272 * MiB;
constexpr size_t WS_END = 1368 * MiB;

constexpr int LDS_BYTES = 155648;
constexpr int LDS_MISC = 153600;
constexpr int NWAVES = 8;

typedef float f32x2_t __attribute__((ext_vector_type(2))); typedef __bf16 bf16x2_t __attribute__((ext_vector_type(2)));
DEV unsigned f2bf(float f) { return (unsigned)__builtin_bit_cast(unsigned short, (__bf16)f); }
DEV unsigned pk2(float lo, float hi) { f32x2_t v = {lo, hi}; bf16x2_t b = __builtin_convertvector(v, bf16x2_t); return __builtin_bit_cast(unsigned, b); }
DEV float bf2f(unsigned short b) { return __builtin_bit_cast(float, (unsigned)b << 16); }
DEV float bflo(unsigned w) { return __builtin_bit_cast(float, w << 16); }
DEV float bfhi(unsigned w) { return __builtin_bit_cast(float, w & 0xffff0000u); }
DEV float sigmoidf_(float x) { return __builtin_amdgcn_rcpf(1.f + __expf(-x)); }
DEV float siluf_(float x) { return x * __builtin_amdgcn_rcpf(1.f + __expf(-x)); }
DEV float softplusf_(float x) { return fmaxf(x, 0.f) + log1pf(__expf(-fabsf(x))); }
DEV float logsigf_(float x) { return fminf(x, 0.f) - log1pf(__expf(-fabsf(x))); }
DEV float ss_to_rstd(u64 s, float inv_n) { return rsqrtf((float)s * (1.f / 4294967296.f) * inv_n + EPS); }
DEV void ss_add(u64* p, float part) { atomicAdd((unsigned long long*)p, (unsigned long long)(part * 4294967296.f)); }
DEV float shx(float v, int m, int lane) { return __uint_as_float((unsigned)__builtin_amdgcn_ds_bpermute((lane ^ m) << 2, (int)__float_as_uint(v))); }
DEV float shup(float v, int d, int lane) { const int src = lane >= d ? lane - d : lane; return __uint_as_float((unsigned)__builtin_amdgcn_ds_bpermute(src << 2, (int)__float_as_uint(v))); }
DEV float xsum16(float v) { auto r = __builtin_amdgcn_permlane16_swap(__float_as_uint(v), __float_as_uint(v), false, false); return __uint_as_float(r[0]) + __uint_as_float(r[1]); }
DEV float xsum32(float v) { auto r = __builtin_amdgcn_permlane32_swap(__float_as_uint(v), __float_as_uint(v), false, false); return __uint_as_float(r[0]) + __uint_as_float(r[1]); }
DEV float wave_sum(float v, int lane) {
#pragma unroll
    for (int o = 1; o < 16; o <<= 1) v += shx(v, o, lane);
    return xsum32(xsum16(v));
}
DEV float wave_max(float v, int lane) {
#pragma unroll
    for (int o = 1; o < 64; o <<= 1) v = fmaxf(v, shx(v, o, lane));
    return v;
}
DEV u32x4 pack8(const float* v) { u32x4 w; w.x = pk2(v[0], v[1]); w.y = pk2(v[2], v[3]); w.z = pk2(v[4], v[5]); w.w = pk2(v[6], v[7]); return w; }
DEV void unpack8(u32x4 w, float* v) { v[0] = bflo(w.x); v[1] = bfhi(w.x); v[2] = bflo(w.y); v[3] = bfhi(w.y); v[4] = bflo(w.z); v[5] = bfhi(w.z); v[6] = bflo(w.w); v[7] = bfhi(w.w); }

typedef f32x4 Acc[2][2][4][2];
#define EPI_ROWS(...) _Pragma("unroll") for (int ai = 0; ai < 2; ++ai) _Pragma("unroll") for (int m = 0; m < 4; ++m) { const int rg = ai * 4 + m; const int row = row0 + ai * 128 + m * 16; __VA_ARGS__ }
DEV void load_rstd8(float (&rs)[8], const u64* ss, int row0, float inv_n) {
    u64 t[8];
#pragma unroll
    for (int rg = 0; rg < 8; ++rg) t[rg] = *(const GAS u64*)(ss + row0 + (rg >> 2) * 128 + (rg & 3) * 16);
#pragma unroll
    for (int rg = 0; rg < 8; ++rg) rs[rg] = ss_to_rstd(t[rg], inv_n);
}
typedef const LAS u64* PrePtr;
DEV void lds_rstd8(float (&rs)[8], PrePtr pre, int fr, float inv_n) {
    u64 t[8];
#pragma unroll
    for (int rg = 0; rg < 8; ++rg) t[rg] = pre[rg * 16 + fr];
#pragma unroll
    for (int rg = 0; rg < 8; ++rg) rs[rg] = ss_to_rstd(t[rg], inv_n);
}
struct EpiSwiGLU {
    static constexpr bool PRE = true; const u64* ss; bf16* U; DEV const u64* pre_ptr() const { return ss; }
    DEV void operator()(const Acc& acc, const pg8::Unit& u, int wr, int wc, int fr, int fq, PrePtr pre) const {
        const int row0 = u.pm * 256 + wr * 64 + fr, col0 = u.pn * 128 + wc * 32 + 8 * fq;
        float rs[8]; lds_rstd8(rs, pre, fr, 1.f / DM);
        EPI_ROWS( float o[8];
            _Pragma("unroll") for (int n = 0; n < 2; ++n) _Pragma("unroll") for (int i = 0; i < 4; ++i) { const float a = acc[ai][0][m][n][i] * rs[rg], b = acc[ai][1][m][n][i] * rs[rg]; o[n * 4 + i] = siluf_(a) * b; }
            *(GAS u32x4*)(U + (size_t)row * FF + col0) = pack8(o); )
    }
};
template <int MODE> struct EpiResid {
    static constexpr bool PRE = false; const bf16* HBi; bf16* HBo; u64* sso; float alpha; const u64* ssi; const bf16* PP;
    DEV void operator()(const Acc& acc, const pg8::Unit& u, int wr, int wc, int fr, int fq, PrePtr pre) const {
        const int row0 = u.pm * 256 + wr * 64 + fr, col0 = u.pn * 256 + wc * 32 + 8 * fq;
        float rs[8]; if (MODE == 1) load_rstd8(rs, ssi, row0, 1.f / DM);
        constexpr int MB = (MODE == 1) ? 2 : 4;
#pragma unroll
        for (int bt = 0; bt < 8 / MB; ++bt) {
            u32x4 hb[MB][2], pq[MB][2];
#pragma unroll
            for (int mm = 0; mm < MB; ++mm)
#pragma unroll
                for (int bj = 0; bj < 2; ++bj) { const int rg = bt * MB + mm; const size_t off = (size_t)(row0 + (rg >> 2) * 128 + (rg & 3) * 16) * DM + col0 + bj * 128;
                    hb[mm][bj] = *(const GAS u32x4*)(HBi + off); if (MODE == 1) pq[mm][bj] = *(const GAS u32x4*)(PP + off); }
            __builtin_amdgcn_sched_barrier(0);
#pragma unroll
            for (int mm = 0; mm < MB; ++mm) { const int rg = bt * MB + mm, ai = rg >> 2, m = rg & 3; const int row = row0 + ai * 128 + m * 16; float part = 0.f;
#pragma unroll
                for (int bj = 0; bj < 2; ++bj) { float hv[8], pv[8], o[8]; unpack8(hb[mm][bj], hv); if (MODE == 1) unpack8(pq[mm][bj], pv);
#pragma unroll
                    for (int n = 0; n < 2; ++n)
#pragma unroll
                        for (int i = 0; i < 4; ++i) { const int e = n * 4 + i;
                            o[e] = (MODE == 0) ? hv[e] + alpha * acc[ai][bj][m][n][i] : hv[e] + sigmoidf_(acc[ai][bj][m][n][i] * rs[rg]) * pv[e]; part += o[e] * o[e]; }
                    *(GAS u32x4*)(HBo + (size_t)row * DM + col0 + bj * 128) = pack8(o); }
                part = xsum32(xsum16(part));
                if (fq == 0) ss_add(sso + row, part); }
        }
    }
};
struct EpiWin {
    static constexpr bool PRE = true; DEV const u64* pre_ptr() const { return ssi; } const u64* ssi; bf16* ZIN; float* SMALL; u64* cqss; u64* ckvss;
    template <bool GATE> DEV void body(const Acc& acc, const pg8::Unit& u, int row0, int cw, int fq, const float (&rs)[8]) const {
        const int pn = u.pn; const bool stat = (pn >= 22 && pn < 26);
        EPI_ROWS( float part = 0.f;
            _Pragma("unroll") for (int bj = 0; bj < 2; ++bj) { float o[8];
                _Pragma("unroll") for (int n = 0; n < 2; ++n) _Pragma("unroll") for (int i = 0; i < 4; ++i) { float v = acc[ai][bj][m][n][i] * rs[rg]; if (!GATE) part += v * v; o[n * 4 + i] = GATE ? sigmoidf_(v) : v; }
                if (GATE || pn < 50) *(GAS u32x4*)(ZIN + (size_t)row * ZW + pn * 256 + bj * 128 + cw) = pack8(o);
                else if (bj == 0) { GAS float* d = (GAS float*)(SMALL + (size_t)row * SMW + cw); *(GAS f32x4*)d = (f32x4){o[0], o[1], o[2], o[3]}; *(GAS f32x4*)(d + 4) = (f32x4){o[4], o[5], o[6], o[7]}; } }
            if (!GATE && stat) { part = xsum32(xsum16(part)); if (fq == 0) ss_add((pn < 24 ? cqss : ckvss) + row, part); } )
    }
    DEV void operator()(const Acc& acc, const pg8::Unit& u, int wr, int wc, int fr, int fq, PrePtr pre) const {
        const int row0 = u.pm * 256 + wr * 64 + fr, cw = wc * 32 + 8 * fq;
        float rs[8]; lds_rstd8(rs, pre, fr, 1.f / DM);
        if (u.pn >= 26 && u.pn < 50) body<true>(acc, u, row0, cw, fq, rs);
        else body<false>(acc, u, row0, cw, fq, rs);
    }
};
struct EpiQup {
    static constexpr bool PRE = true; DEV const u64* pre_ptr() const { return ss; } const u64* ss; bf16* Q; const float* COS; const float* SIN;
    DEV void operator()(const Acc& acc, const pg8::Unit& u, int wr, int wc, int fr, int fq, PrePtr pre) const {
        const int row0 = u.pm * 256 + wr * 64 + fr, pn = u.pn;
        float rs[8]; lds_rstd8(rs, pre, fr, 1.f / 512.f);
        EPI_ROWS( const int b = row >> 13, s = row & (SEQ - 1);
            if (pn < 4) {
                _Pragma("unroll") for (int bj = 0; bj < 2; ++bj) { const int head = 2 * pn + bj; float o[8];
                    _Pragma("unroll") for (int n = 0; n < 2; ++n) _Pragma("unroll") for (int i = 0; i < 4; ++i) o[n * 4 + i] = acc[ai][bj][m][n][i] * rs[rg];
                    *(GAS u32x4*)(Q + ((size_t)(b * 8 + head) * SEQ + s) * 192 + wc * 32 + 8 * fq) = pack8(o); }
            } else { const int head = 4 * (pn - 4) + wc, j0 = 8 * fq; float o1[8], o2[8];
                const f32x4 c0 = *(const GAS f32x4*)(COS + (size_t)row * 32 + j0), c1 = *(const GAS f32x4*)(COS + (size_t)row * 32 + j0 + 4);
                const f32x4 s0 = *(const GAS f32x4*)(SIN + (size_t)row * 32 + j0), s1 = *(const GAS f32x4*)(SIN + (size_t)row * 32 + j0 + 4);
                _Pragma("unroll") for (int n = 0; n < 2; ++n) _Pragma("unroll") for (int i = 0; i < 4; ++i) { const float x1 = acc[ai][0][m][n][i] * rs[rg], x2 = acc[ai][1][m][n][i] * rs[rg]; const float cs = n ? c1[i] : c0[i], sn = n ? s1[i] : s0[i];
                    o1[n * 4 + i] = x1 * cs - x2 * sn; o2[n * 4 + i] = x2 * cs + x1 * sn; }
                bf16* qp = Q + ((size_t)(b * 8 + head) * SEQ + s) * 192 + 128 + j0;
                *(GAS u32x4*)qp = pack8(o1); *(GAS u32x4*)(qp + 32) = pack8(o2); } )
    }
};
struct EpiKVup {
    static constexpr bool PRE = true; DEV const u64* pre_ptr() const { return ss; } const u64* ss; bf16* KN; bf16* V;
    DEV void operator()(const Acc& acc, const pg8::Unit& u, int wr, int wc, int fr, int fq, PrePtr pre) const {
        const int row0 = u.pm * 256 + wr * 64 + fr, head = u.pn;
        float rs[8]; lds_rstd8(rs, pre, fr, 1.f / 512.f);
        EPI_ROWS( const int b = row >> 13, s = row & (SEQ - 1); const size_t off = ((size_t)(b * 8 + head) * SEQ + s) * 128 + wc * 32 + 8 * fq;
            _Pragma("unroll") for (int bj = 0; bj < 2; ++bj) { float o[8];
                _Pragma("unroll") for (int n = 0; n < 2; ++n) _Pragma("unroll") for (int i = 0; i < 4; ++i) o[n * 4 + i] = acc[ai][bj][m][n][i] * rs[rg];
                *(GAS u32x4*)((bj ? V : KN) + off) = pack8(o); } )
    }
};
struct EpiPlain {
    static constexpr bool PRE = false; bf16* O; int ldc;
    DEV void operator()(const Acc& acc, const pg8::Unit& u, int wr, int wc, int fr, int fq, PrePtr pre) const {
        const int row0 = u.pm * 256 + wr * 64 + fr, col0 = u.pn * 256 + wc * 32 + 8 * fq;
        EPI_ROWS( (void)rg;
            _Pragma("unroll") for (int bj = 0; bj < 2; ++bj) { float o[8];
                _Pragma("unroll") for (int n = 0; n < 2; ++n) _Pragma("unroll") for (int i = 0; i < 4; ++i) o[n * 4 + i] = acc[ai][bj][m][n][i];
                *(GAS u32x4*)(O + (size_t)row * ldc + col0 + bj * 128) = pack8(o); } )
    }
};
#ifndef DBG_DBL
#define DBG_DBL 0
#endif
#ifndef DBG_ZERO
#define DBG_ZERO 0
#endif
struct EpiBranch {
    static constexpr bool PRE = false; const bf16* ZIN; const u64* ybss; bf16* MERGEB;
    DEV void operator()(const Acc& acc, const pg8::Unit& u, int wr, int wc, int fr, int fq, PrePtr pre) const {
        const int j = u.pm >> 6, pm = u.pm & 63, pn = u.pn & 7;
        const int row0 = pm * 256 + wr * 64 + fr, col0 = pn * 256 + wc * 32 + 8 * fq;
        float rs[8];
        if (j == 1) load_rstd8(rs, ybss, row0, 1.f / 1024.f);
        else {
#pragma unroll
            for (int rg = 0; rg < 8; ++rg) rs[rg] = 1.f; }
        u32x4 gq[2][2], mq[2][2];
#define BR_LOAD(slot, rgx) _Pragma("unroll") for (int bj = 0; bj < 2; ++bj) { const int row = row0 + ((rgx) >> 2) * 128 + ((rgx) & 3) * 16, col = col0 + bj * 128; \
            gq[slot][bj] = *(const GAS u32x4*)(ZIN + (size_t)row * ZW + ZC_GATE + j * DM + col); \
            mq[slot][bj] = (u32x4){0u, 0u, 0u, 0u}; if (j > 0) mq[slot][bj] = *(const GAS u32x4*)(MERGEB + (size_t)row * DM + col); }
        BR_LOAD(0, 0)
#pragma unroll
        for (int rg = 0; rg < 8; ++rg) {
            if (rg + 1 < 8) { if ((rg & 1) == 0) { BR_LOAD(1, rg + 1) } else { BR_LOAD(0, rg + 1) } }
            __builtin_amdgcn_sched_barrier(0);
#pragma unroll
            for (int bj = 0; bj < 2; ++bj) { const int ai = rg >> 2, m = rg & 3; const int row = row0 + ai * 128 + m * 16, col = col0 + bj * 128; float g[8], p[8], o[8]; unpack8(gq[rg & 1][bj], g); unpack8(mq[rg & 1][bj], p);
#pragma unroll
                for (int n = 0; n < 2; ++n)
#pragma unroll
                    for (int i = 0; i < 4; ++i) o[n * 4 + i] = p[n * 4 + i] + (((DBG_ZERO >> j) & 1) ? 0.f : acc[ai][bj][m][n][i] * rs[rg] * g[n * 4 + i] * (((DBG_DBL >> j) & 1) ? 2.f : 1.f));
                *(GAS u32x4*)(MERGEB + (size_t)row * DM + col) = pack8(o); }
        }
#undef BR_LOAD
    }
};
#undef EPI_ROWS
struct Params {
    const float* in[30];
    float* out; unsigned char* ws;
    int l_lo, l_hi, ph_lo, ph_hi;
    int use_bar, pad;
};
enum { I_X = 0, I_P, I_POS, I_F1N, I_F1W13, I_F1W2, I_MIXN, I_WIN, I_BIG, I_BFG, I_MLN, I_CONVW, I_CONVB, I_ALOG, I_DTB, I_SSD, I_SSN,
       I_QN, I_KVN, I_WUQ, I_WUKV, I_WBR, I_WOUT, I_F2N, I_F2W13, I_F2W2, I_PLN, I_WPG, I_WPP, I_FIN };

struct Ctx {
    LAS unsigned char* lds; unsigned char* ws; int tid, lane, wave, G, bid;
};
DEV Ctx fresh(const Ctx& C0) { Ctx C = C0;
    int wv = C0.wave; unsigned char* w = C0.ws; int g = C0.G, b = C0.bid; asm volatile("" : "+s"(wv), "+s"(w), "+s"(g), "+s"(b));
    int ln = (int)__builtin_amdgcn_mbcnt_hi(~0u, __builtin_amdgcn_mbcnt_lo(~0u, 0u)); asm volatile("" : "+v"(ln));
    C.wave = wv; C.lane = ln; C.tid = wv * 64 + ln; C.ws = w; C.G = g; C.bid = b; return C; }

__constant__ double INVF[32] = {1.0, 0.7498942093324559, 0.5623413251903491, 0.4216965034285822, 0.31622776601683794, 0.23713737056616552, 0.1778279410038923, 0.1333521432163324, 0.1, 0.07498942093324558, 0.05623413251903491, 0.042169650342858224, 0.03162277660168379, 0.023713737056616554, 0.01778279410038923, 0.01333521432163324, 0.01, 0.007498942093324558, 0.005623413251903491, 0.004216965034285823, 0.0031622776601683794, 0.0023713737056616554, 0.0017782794100389228, 0.001333521432163324, 0.001, 0.0007498942093324559, 0.0005623413251903491, 0.00042169650342858224, 0.00031622776601683794, 0.00023713737056616554, 0.00017782794100389227, 0.0001333521432163324};
struct MapId  { DEV int operator()(int r) const { return r; } };
struct MapW13 { DEV int operator()(int r) const { const int t = r >> 8, w = r & 255; return (w >= 128 ? FF : 0) + 128 * t + (w & 127); } };
struct MapWin { DEV int operator()(int r) const {
    if (r < 3072) return r; if (r < 5632) return r + 16; if (r < 6656) return r + 48; if (r < 12800) return r + 112;
    r -= 12800; if (r < 16) return 3072 + r; if (r < 48) return 5648 + (r - 16); if (r < 112) return 6704 + (r - 48); return -1; } };
struct MapUq  { DEV int operator()(int r) const {
    if (r < 1024) return (r >> 7) * 192 + (r & 127);
    const int rr = r - 1024, tile = rr >> 8, w = rr & 255, t2 = w >> 7, hl = (w & 127) >> 5, j = w & 31; return (4 * tile + hl) * 192 + 128 + 32 * t2 + j; } };

struct CvtItem { const float* W; const float* gain; bf16* WT; int ldw, K, sc, kk0, row; };
DEV int cvt_map(int id, int r) { return id == 0 ? MapId()(r) : id == 1 ? MapW13()(r) : id == 2 ? MapWin()(r) : MapUq()(r); }
DEV CvtItem cvt_describe(const Params& P, unsigned char* ws, int L, int it, int lane) {
    constexpr int N13 = (2 * FF / 64) * (DM / 64), N2 = (DM / 64) * (FF / 64), NIN = (WIN_ROWS / 64) * (DM / 64), NUQ = (1536 / 64) * (512 / 64), NUKV = (2048 / 64) * (512 / 64),
                  NBR = (DM / 64) * (1024 / 64), NSQ = (DM / 64) * (DM / 64);
    bf16* WB = (bf16*)(ws + WS_W); CvtItem d; int r = it, mapid = 0;
    if (r < N13) { d.W = P.in[I_F1W13] + (size_t)L * DM * 2 * FF; d.ldw = 2 * FF; d.K = DM; d.gain = P.in[I_F1N] + L * DM; d.WT = WB + WE_13A; mapid = 1; }
    else if ((r -= N13) < N13) { d.W = P.in[I_F2W13] + (size_t)L * DM * 2 * FF; d.ldw = 2 * FF; d.K = DM; d.gain = P.in[I_F2N] + L * DM; d.WT = WB + WE_13B; mapid = 1; }
    else if ((r -= N13) < N2) { d.W = P.in[I_F1W2] + (size_t)L * FF * DM; d.ldw = DM; d.K = FF; d.gain = nullptr; d.WT = WB + WE_2A; }
    else if ((r -= N2) < N2) { d.W = P.in[I_F2W2] + (size_t)L * FF * DM; d.ldw = DM; d.K = FF; d.gain = nullptr; d.WT = WB + WE_2B; }
    else if ((r -= N2) < NIN) { d.W = P.in[I_WIN] + (size_t)L * DM * DIN_SRC; d.ldw = DIN_SRC; d.K = DM; d.gain = P.in[I_MIXN] + L * DM; d.WT = WB + WE_IN; mapid = 2; }
    else if ((r -= NIN) < NUQ) { d.W = P.in[I_WUQ] + (size_t)L * 512 * 1536; d.ldw = 1536; d.K = 512; d.gain = P.in[I_QN] + L * 512; d.WT = WB + WE_UQ; mapid = 3; }
    else if ((r -= NUQ) < NUKV) { d.W = P.in[I_WUKV] + (size_t)L * 512 * 2048; d.ldw = 2048; d.K = 512; d.gain = P.in[I_KVN] + L * 512; d.WT = WB + WE_UKV; }
    else if ((r -= NUKV) < 3 * NBR) { const int j = r / NBR; r -= j * NBR; d.W = P.in[I_WBR] + (size_t)L * 3 * 1024 * DM + (size_t)j * 1024 * DM; d.ldw = DM; d.K = 1024; d.gain = (j == 1) ? P.in[I_SSN] + L * 1024 : nullptr; d.WT = WB + WE_BR + (size_t)j * DM * 1024; }
    else if ((r -= 3 * NBR) < NSQ) { d.W = P.in[I_WOUT] + (size_t)L * DM * DM; d.ldw = DM; d.K = DM; d.gain = nullptr; d.WT = WB + WE_OUT; }
    else if ((r -= NSQ) < NSQ) { d.W = P.in[I_WPG] + (size_t)L * DM * DM; d.ldw = DM; d.K = DM; d.gain = P.in[I_PLN] + L * DM; d.WT = WB + WE_PG; }
    else { r -= NSQ; d.W = P.in[I_WPP] + (size_t)L * PLE * DM; d.ldw = DM; d.K = PLE; d.gain = nullptr; d.WT = WB + WE_PP; }
    const int nkb = d.K / 64, rb = r / nkb, kb = r - rb * nkb; d.row = 64 * rb + (lane & 15) * 4; d.kk0 = 64 * kb + 16 * (lane >> 4); d.sc = cvt_map(mapid, d.row);
    return d;
}
DEV void cvt_load(const CvtItem& d, f32x4 (&v)[16]) {
#pragma unroll
    for (int i = 0; i < 16; ++i) { v[i] = (f32x4){0.f, 0.f, 0.f, 0.f}; if (d.sc >= 0) v[i] = *(const GAS f32x4*)(d.W + (size_t)(d.kk0 + i) * d.ldw + d.sc); }
}
DEV void cvt_store(const CvtItem& d, const f32x4 (&v)[16]) {
    f32x4 g[4];
#pragma unroll
    for (int q = 0; q < 4; ++q) g[q] = d.gain ? *(const GAS f32x4*)(d.gain + d.kk0 + 4 * q) : (f32x4){1.f, 1.f, 1.f, 1.f};
#pragma unroll
    for (int jn = 0; jn < 4; ++jn) { u32x4 o0, o1;
        o0.x = pk2(v[0][jn] * g[0][0], v[1][jn] * g[0][1]); o0.y = pk2(v[2][jn] * g[0][2], v[3][jn] * g[0][3]); o0.z = pk2(v[4][jn] * g[1][0], v[5][jn] * g[1][1]); o0.w = pk2(v[6][jn] * g[1][2], v[7][jn] * g[1][3]);
        o1.x = pk2(v[8][jn] * g[2][0], v[9][jn] * g[2][1]); o1.y = pk2(v[10][jn] * g[2][2], v[11][jn] * g[2][3]); o1.z = pk2(v[12][jn] * g[3][0], v[13][jn] * g[3][1]); o1.w = pk2(v[14][jn] * g[3][2], v[15][jn] * g[3][3]);
        bf16* p = d.WT + (size_t)(d.row + jn) * d.K + d.kk0;
        *(GAS u32x4*)p = o0; *(GAS u32x4*)(p + 8) = o1; }
}

DEV void phase_convert(const Params& P, const Ctx& C0, int L) {
    const Ctx C = fresh(C0);
    const int gw = C.bid * NWAVES + C.wave, NGW = C.G * NWAVES, lane = C.lane;
    constexpr int NITEMS = 2 * (2 * FF / 64) * (DM / 64) + 2 * (DM / 64) * (FF / 64) + (WIN_ROWS / 64) * (DM / 64) + (1536 / 64) * (512 / 64) + (2048 / 64) * (512 / 64)
                         + 3 * (DM / 64) * (1024 / 64) + 2 * (DM / 64) * (DM / 64) + (DM / 64) * (PLE / 64);
    if (gw < NITEMS) {
        f32x4 va[16], vb[16]; CvtItem da = cvt_describe(P, C.ws, L, gw, lane), db = da; cvt_load(da, va);
        for (int it = gw;;) {
            const int itb = it + NGW; const bool hb = itb < NITEMS;
            if (hb) { db = cvt_describe(P, C.ws, L, itb, lane); cvt_load(db, vb); }
            cvt_store(da, va); if (!hb) break;
            const int ita = itb + NGW; const bool ha = ita < NITEMS;
            if (ha) { da = cvt_describe(P, C.ws, L, ita, lane); cvt_load(da, va); }
            cvt_store(db, vb); if (!ha) break;
            it = ita;
        }
    }
    { const float* p = P.in[I_P] + (size_t)L * M * PLE; bf16* PB = (bf16*)(C.ws + WS_PB);
      const int gt = C.bid * 512 + C.tid, NGT = C.G * 512;
      for (int i = gt; i < M * PLE / 8; i += NGT) { const f32x4 a = *(const f32x4*)(p + (size_t)i * 8), b = *(const f32x4*)(p + (size_t)i * 8 + 4);
          u32x4 o; o.x = pk2(a[0], a[1]); o.y = pk2(a[2], a[3]); o.z = pk2(b[0], b[1]); o.w = pk2(b[2], b[3]); *(u32x4*)(PB + (size_t)i * 8) = o; } }
    if (L == 0) {
        const float* x = P.in[I_X]; bf16* HB = (bf16*)(C.ws + WS_HB0); u64* hss = (u64*)(C.ws + OFF_HSS);
        for (int m = gw; m < M; m += NGW) { float s = 0.f;
#pragma unroll
            for (int j = 0; j < 4; ++j) { const size_t off = (size_t)m * DM + j * 512 + lane * 8; const f32x4 a = *(const f32x4*)(x + off), b = *(const f32x4*)(x + off + 4);
                u32x4 o; o.x = pk2(a[0], a[1]); o.y = pk2(a[2], a[3]); o.z = pk2(b[0], b[1]); o.w = pk2(b[2], b[3]); *(u32x4*)(HB + off) = o;
                s += a[0] * a[0] + a[1] * a[1] + a[2] * a[2] + a[3] * a[3] + b[0] * b[0] + b[1] * b[1] + b[2] * b[2] + b[3] * b[3]; }
            s = wave_sum(s, lane); if (lane == 0) hss[m] = (u64)(s * 4294967296.f); }
    }
}

DEV void rope_tables(const Params& P, const Ctx& C0) {
    const Ctx C = fresh(C0);
        const int* pos = (const int*)P.in[I_POS]; float* COS = (float*)(C.ws + WS_COS); float* SIN = (float*)(C.ws + WS_SIN);
        const int gt = C.bid * 512 + C.tid, NGT = C.G * 512;
        for (int i = gt; i < M * 32; i += NGT) { const int m = i >> 5, j = i & 31; const double ang = (double)pos[m] * INVF[j];
            const double n = rint(ang * 0.6366197723675814); double r = fma(-n, 1.5707963267948966, ang); r = fma(-n, 6.123233995736766e-17, r);
            const double r2 = r * r;
            double sn = 1.0 / 6227020800.0; sn = fma(sn, r2, -1.0 / 39916800.0); sn = fma(sn, r2, 1.0 / 362880.0); sn = fma(sn, r2, -1.0 / 5040.0); sn = fma(sn, r2, 1.0 / 120.0); sn = fma(sn, r2, -1.0 / 6.0); sn = fma(sn * r2, r, r);
            double cs = -1.0 / 87178291200.0; cs = fma(cs, r2, 1.0 / 479001600.0); cs = fma(cs, r2, -1.0 / 3628800.0); cs = fma(cs, r2, 1.0 / 40320.0); cs = fma(cs, r2, -1.0 / 720.0); cs = fma(cs, r2, 1.0 / 24.0); cs = fma(cs, r2, -0.5); cs = fma(cs, r2, 1.0);
            const int q = ((int)n) & 3; const double so = (q == 0) ? sn : (q == 1) ? cs : (q == 2) ? -sn : -cs; const double co = (q == 0) ? cs : (q == 1) ? -sn : (q == 2) ? -cs : sn;
            COS[i] = (float)co; SIN[i] = (float)so; }
}
namespace att {
constexpr int NW = 8, QBLK = 32, KVBLK = 64;
constexpr float SCALE = 0.07216878364870323f;
constexpr float THR = 8.f;
constexpr int LDQ = 192, LDK = 128, LDR = 64, LDO = 1024;
constexpr int SHM_V = KVBLK * 128 * 2, SHM_K = KVBLK * 128 * 2, SHM_R = KVBLK * 64 * 2;
constexpr int NBUF = 3;
constexpr int OFF_V = 0, OFF_K = NBUF * SHM_V, OFF_R = OFF_K + NBUF * SHM_K, OFF_WS = OFF_R + NBUF * SHM_R, SHM_ATTN = OFF_WS + NW * 64 * 4;
#define KSWZ(row, colB) ((row) * 256 + ((colB) ^ (((row) & 7) << 4)))
#define RSWZ(row, colB) ((row) * 128 + ((colB) ^ (((row) & 7) << 4)))
#define SBAR() __builtin_amdgcn_sched_barrier(0)
DEV int crow(int r, int hi) { return (r & 3) + 8 * (r >> 2) + 4 * hi; }
DEV unsigned cvtpk(float lo, float hi) { return pk2(lo, hi); }
DEV bf16x8 ld8(const bf16* p) { return *(const GAS bf16x8*)p; }

template <int ST> DEV void partialSM_part(f32x16& p0, f32x16& p1, float& m_reg, float& mn, float& alpha, float& pmax, float& mnC) {
  constexpr float C = SCALE * 1.4426950408889634f;
  if constexpr (ST == 0) {
    pmax = p0[0];
#pragma unroll
    for (int r = 1; r < 16; ++r) pmax = fmaxf(pmax, p0[r]);
#pragma unroll
    for (int r = 0; r < 16; ++r) pmax = fmaxf(pmax, p1[r]);
    { auto rr = __builtin_amdgcn_permlane32_swap(__float_as_uint(pmax), __float_as_uint(pmax), false, false);
      pmax = fmaxf(__uint_as_float(rr[0]), __uint_as_float(rr[1])); }
  } else if constexpr (ST == 1) {
    if (__builtin_expect(__all(pmax - m_reg <= THR / SCALE), 1)) { mn = m_reg; alpha = 1.f; }
    else { mn = fmaxf(m_reg, pmax); alpha = __builtin_amdgcn_exp2f((m_reg - mn) * C); m_reg = mn; }
    mnC = -mn * C;
#pragma unroll
    for (int r = 0; r < 16; ++r) p0[r] = fmaf(p0[r], C, mnC);
#pragma unroll
    for (int r = 0; r < 8; ++r) p1[r] = fmaf(p1[r], C, mnC);
  } else if constexpr (ST == 2) {
#pragma unroll
    for (int r = 8; r < 16; ++r) p1[r] = fmaf(p1[r], C, mnC);
#pragma unroll
    for (int r = 0; r < 6; ++r) p0[r] = __builtin_amdgcn_exp2f(p0[r]);
    asm volatile("" : "+v"(p0));
  } else {
#pragma unroll
    for (int r = 6; r < 16; ++r) p0[r] = __builtin_amdgcn_exp2f(p0[r]);
    asm volatile("" : "+v"(p0));
  }
}
DEV void partialSM(f32x16& p0, f32x16& p1, float& m_reg, float& mn, float& alpha) {
  float pmax, mnC;
  partialSM_part<0>(p0, p1, m_reg, mn, alpha, pmax, mnC); partialSM_part<1>(p0, p1, m_reg, mn, alpha, pmax, mnC);
  partialSM_part<2>(p0, p1, m_reg, mn, alpha, pmax, mnC); partialSM_part<3>(p0, p1, m_reg, mn, alpha, pmax, mnC);
}
struct FinSM { float ps; };
#define PK4(P, BASE, OUT) do { u32x4 w = {cvtpk(P[BASE + 0], P[BASE + 1]), cvtpk(P[BASE + 2], P[BASE + 3]), cvtpk(P[BASE + 4], P[BASE + 5]), cvtpk(P[BASE + 6], P[BASE + 7])}; \
    OUT = *reinterpret_cast<bf16x8*>(&w); } while (0)
template <int ST> DEV void finishSM_part(f32x16& p0, f32x16& p1, float alpha, float& l_reg, float& ps, bf16x8& pa0, bf16x8& pa1, bf16x8& pa2, bf16x8& pa3) {
  if constexpr (ST < 8) {
    p1[2 * ST] = __builtin_amdgcn_exp2f(p1[2 * ST]); p1[2 * ST + 1] = __builtin_amdgcn_exp2f(p1[2 * ST + 1]);
    if constexpr (ST == 0) ps = p0[0] + p0[1]; else ps += p0[2 * ST] + p0[2 * ST + 1];
    if constexpr (ST > 0) ps += p1[2 * ST - 2] + p1[2 * ST - 1];
  } else if constexpr (ST == 8) {
    ps += p1[14] + p1[15];
    { auto rr = __builtin_amdgcn_permlane32_swap(__float_as_uint(ps), __float_as_uint(ps), false, false);
      ps = __uint_as_float(rr[0]) + __uint_as_float(rr[1]); }
    l_reg = l_reg * alpha + ps;
    PK4(p0, 0, pa0);
  } else if constexpr (ST == 9) { PK4(p0, 8, pa1); }
  else if constexpr (ST == 10) { PK4(p1, 0, pa2); }
  else { PK4(p1, 8, pa3); }
}
DEV void finishSM(f32x16& p0, f32x16& p1, float alpha, float& l_reg, bf16x8& pa0, bf16x8& pa1, bf16x8& pa2, bf16x8& pa3) {
  float ps;
  finishSM_part<0>(p0, p1, alpha, l_reg, ps, pa0, pa1, pa2, pa3); finishSM_part<1>(p0, p1, alpha, l_reg, ps, pa0, pa1, pa2, pa3); finishSM_part<2>(p0, p1, alpha, l_reg, ps, pa0, pa1, pa2, pa3);
  finishSM_part<3>(p0, p1, alpha, l_reg, ps, pa0, pa1, pa2, pa3); finishSM_part<4>(p0, p1, alpha, l_reg, ps, pa0, pa1, pa2, pa3); finishSM_part<5>(p0, p1, alpha, l_reg, ps, pa0, pa1, pa2, pa3);
  finishSM_part<6>(p0, p1, alpha, l_reg, ps, pa0, pa1, pa2, pa3); finishSM_part<7>(p0, p1, alpha, l_reg, ps, pa0, pa1, pa2, pa3); finishSM_part<8>(p0, p1, alpha, l_reg, ps, pa0, pa1, pa2, pa3);
  finishSM_part<9>(p0, p1, alpha, l_reg, ps, pa0, pa1, pa2, pa3); finishSM_part<10>(p0, p1, alpha, l_reg, ps, pa0, pa1, pa2, pa3); finishSM_part<11>(p0, p1, alpha, l_reg, ps, pa0, pa1, pa2, pa3);
}
template <int OFF> DEV bf16x8 rd128(int a) { bf16x8 r; asm volatile("ds_read_b128 %0, %1 offset:%2" : "=&v"(r) : "v"(a), "i"(OFF) : "memory"); return r; }
DEV void qkt(f32x16& p0, f32x16& p1, int ka0, int ra0, int kof, int rof, const bf16x8* qr) {
  const int ka = ka0 + kof, ra = ra0 + rof;
  p0 = f32x16{}; p1 = f32x16{};
  bf16x8 f[2][2];
#define RDK(d, s) do { const int a_ = ka ^ ((d) * 32); f[s][0] = rd128<0>(a_); f[s][1] = rd128<8192>(a_); } while (0)
#define RDR(d, s) do { const int a_ = ra ^ ((d) * 32); f[s][0] = rd128<0>(a_); f[s][1] = rd128<4096>(a_); } while (0)
#define WAIT2(s) asm volatile("s_waitcnt lgkmcnt(2)" : "+v"(f[s][0]), "+v"(f[s][1]) :: "memory")
#define WAIT0(s) asm volatile("s_waitcnt lgkmcnt(0)" : "+v"(f[s][0]), "+v"(f[s][1]) :: "memory")
#define MMA(d, s) do { p0 = __builtin_amdgcn_mfma_f32_32x32x16_bf16(f[s][0], qr[d], p0, 0, 0, 0); p1 = __builtin_amdgcn_mfma_f32_32x32x16_bf16(f[s][1], qr[d], p1, 0, 0, 0); } while (0)
  RDK(0, 0);
  RDK(1, 1); WAIT2(0); MMA(0, 0);
  RDK(2, 0); WAIT2(1); MMA(1, 1);
  RDK(3, 1); WAIT2(0); MMA(2, 0);
  RDK(4, 0); WAIT2(1); MMA(3, 1);
  RDK(5, 1); WAIT2(0); MMA(4, 0);
  RDK(6, 0); WAIT2(1); MMA(5, 1);
  RDK(7, 1); WAIT2(0); MMA(6, 0);
  RDR(0, 0); WAIT2(1); MMA(7, 1);
  RDR(1, 1); WAIT2(0); MMA(8, 0);
  RDR(2, 0); WAIT2(1); MMA(9, 1);
  RDR(3, 1); WAIT2(0); MMA(10, 0);
  WAIT0(1); MMA(11, 1);
#undef RDK
#undef RDR
#undef WAIT2
#undef WAIT0
#undef MMA
}
DEV void qkt_fin(f32x16& p0, f32x16& p1, int ka0, int ra0, int kof, int rof, const bf16x8* qr,
                 f32x16& f0, f32x16& f1, float alpha, float& l_reg, bf16x8& pa0, bf16x8& pa1, bf16x8& pa2, bf16x8& pa3) {
  const int ka = ka0 + kof, ra = ra0 + rof;
  p0 = f32x16{}; p1 = f32x16{};
  bf16x8 f[2][2]; float ps;
#define RDK(d, s) do { const int a_ = ka ^ ((d) * 32); f[s][0] = rd128<0>(a_); f[s][1] = rd128<8192>(a_); } while (0)
#define RDR(d, s) do { const int a_ = ra ^ ((d) * 32); f[s][0] = rd128<0>(a_); f[s][1] = rd128<4096>(a_); } while (0)
#define WAIT2(s) asm volatile("s_waitcnt lgkmcnt(2)" : "+v"(f[s][0]), "+v"(f[s][1]) :: "memory")
#define WAIT0(s) asm volatile("s_waitcnt lgkmcnt(0)" : "+v"(f[s][0]), "+v"(f[s][1]) :: "memory")
#define MMA(d, s) do { p0 = __builtin_amdgcn_mfma_f32_32x32x16_bf16(f[s][0], qr[d], p0, 0, 0, 0); p1 = __builtin_amdgcn_mfma_f32_32x32x16_bf16(f[s][1], qr[d], p1, 0, 0, 0); \
    SBAR(); finishSM_part<d>(f0, f1, alpha, l_reg, ps, pa0, pa1, pa2, pa3); SBAR(); } while (0)
  RDK(0, 0);
  RDK(1, 1); WAIT2(0); MMA(0, 0);
  RDK(2, 0); WAIT2(1); MMA(1, 1);
  RDK(3, 1); WAIT2(0); MMA(2, 0);
  RDK(4, 0); WAIT2(1); MMA(3, 1);
  RDK(5, 1); WAIT2(0); MMA(4, 0);
  RDK(6, 0); WAIT2(1); MMA(5, 1);
  RDK(7, 1); WAIT2(0); MMA(6, 0);
  RDR(0, 0); WAIT2(1); MMA(7, 1);
  RDR(1, 1); WAIT2(0); MMA(8, 0);
  RDR(2, 0); WAIT2(1); MMA(9, 1);
  RDR(3, 1); WAIT2(0); MMA(10, 0);
  WAIT0(1); MMA(11, 1);
#undef RDK
#undef RDR
#undef WAIT2
#undef WAIT0
#undef MMA
}
DEV int v_st(int k, int c) { const int kk = (k & ~0xC) | ((k & 4) << 1) | ((k & 8) >> 1); return ((kk >> 3) * 4 + (c >> 5)) * 512 + ((kk & 7) * 32 + (c & 31)) * 2; }
DEV int v_rd_base(int lane) { return ((lane & 3) << 3) | (((lane >> 2) & 3) << 6) | (((lane >> 4) & 1) << 5) | (((lane >> 5) & 1) << 8); }
constexpr int v_rd_off(int d0, int ks, int half) { return d0 * 512 + ks * 4096 + half * 2048; }
template <int OFF> DEV s16x4 tr_read(int vb) {
  s16x4 r; asm volatile("ds_read_b64_tr_b16 %0, %1 offset:%2" : "=&v"(r) : "v"(vb), "i"(OFF) : "memory"); return r;
}
template <int D0> DEV void pv_one(f32x16& od, int vb, bf16x8 pa0, bf16x8 pa1, bf16x8 pa2, bf16x8 pa3) {
  const s16x4 l0 = tr_read<v_rd_off(D0, 0, 0)>(vb), h0 = tr_read<v_rd_off(D0, 0, 1)>(vb), l1 = tr_read<v_rd_off(D0, 1, 0)>(vb), h1 = tr_read<v_rd_off(D0, 1, 1)>(vb);
  const s16x4 l2 = tr_read<v_rd_off(D0, 2, 0)>(vb), h2 = tr_read<v_rd_off(D0, 2, 1)>(vb), l3 = tr_read<v_rd_off(D0, 3, 0)>(vb), h3 = tr_read<v_rd_off(D0, 3, 1)>(vb);
  asm volatile("s_waitcnt lgkmcnt(0)" ::: "memory"); SBAR();
#define PK(L, H) (bf16x8){L[0], L[1], L[2], L[3], H[0], H[1], H[2], H[3]}
  od = __builtin_amdgcn_mfma_f32_32x32x16_bf16(pa0, PK(l0, h0), od, 0, 0, 0);
  od = __builtin_amdgcn_mfma_f32_32x32x16_bf16(pa1, PK(l1, h1), od, 0, 0, 0);
  od = __builtin_amdgcn_mfma_f32_32x32x16_bf16(pa2, PK(l2, h2), od, 0, 0, 0);
  od = __builtin_amdgcn_mfma_f32_32x32x16_bf16(pa3, PK(l3, h3), od, 0, 0, 0);
#undef PK
}
DEV void pv_d0(f32x16* o, int vb, bf16x8 pa0, bf16x8 pa1, bf16x8 pa2, bf16x8 pa3) {
  pv_one<0>(o[0], vb, pa0, pa1, pa2, pa3); pv_one<1>(o[1], vb, pa0, pa1, pa2, pa3); pv_one<2>(o[2], vb, pa0, pa1, pa2, pa3); pv_one<3>(o[3], vb, pa0, pa1, pa2, pa3);
}

struct VFrag { s16x4 l0, h0, l1, h1, l2, h2, l3, h3; };
template <int D0> DEV void pv_read(VFrag& f, int vb) {
  f.l0 = tr_read<v_rd_off(D0, 0, 0)>(vb); f.h0 = tr_read<v_rd_off(D0, 0, 1)>(vb); f.l1 = tr_read<v_rd_off(D0, 1, 0)>(vb); f.h1 = tr_read<v_rd_off(D0, 1, 1)>(vb);
  f.l2 = tr_read<v_rd_off(D0, 2, 0)>(vb); f.h2 = tr_read<v_rd_off(D0, 2, 1)>(vb); f.l3 = tr_read<v_rd_off(D0, 3, 0)>(vb); f.h3 = tr_read<v_rd_off(D0, 3, 1)>(vb);
}
DEV void pv_wait(VFrag& f) {
  asm volatile("s_waitcnt lgkmcnt(0)" : "+v"(f.l0), "+v"(f.h0), "+v"(f.l1), "+v"(f.h1), "+v"(f.l2), "+v"(f.h2), "+v"(f.l3), "+v"(f.h3) :: "memory");
}
DEV void pv_mma(f32x16& od, const VFrag& f, bf16x8 pa0, bf16x8 pa1, bf16x8 pa2, bf16x8 pa3) {
#define PK(L, H) (bf16x8){L[0], L[1], L[2], L[3], H[0], H[1], H[2], H[3]}
  od = __builtin_amdgcn_mfma_f32_32x32x16_bf16(pa0, PK(f.l0, f.h0), od, 0, 0, 0);
  od = __builtin_amdgcn_mfma_f32_32x32x16_bf16(pa1, PK(f.l1, f.h1), od, 0, 0, 0);
  od = __builtin_amdgcn_mfma_f32_32x32x16_bf16(pa2, PK(f.l2, f.h2), od, 0, 0, 0);
  od = __builtin_amdgcn_mfma_f32_32x32x16_bf16(pa3, PK(f.l3, f.h3), od, 0, 0, 0);
#undef PK
}
DEV void pv_psm(f32x16* o, int vb, bf16x8 pa0, bf16x8 pa1, bf16x8 pa2, bf16x8 pa3, f32x16& q0, f32x16& q1, float& m_reg, float& mn, float& alpha) {
  VFrag fa, fb; float pmax, mnC;
  pv_read<0>(fa, vb);
  pv_wait(fa); pv_mma(o[0], fa, pa0, pa1, pa2, pa3); pv_read<1>(fb, vb); SBAR(); partialSM_part<0>(q0, q1, m_reg, mn, alpha, pmax, mnC); SBAR();
  pv_wait(fb); pv_mma(o[1], fb, pa0, pa1, pa2, pa3); pv_read<2>(fa, vb); SBAR(); partialSM_part<1>(q0, q1, m_reg, mn, alpha, pmax, mnC); SBAR();
  pv_wait(fa); pv_mma(o[2], fa, pa0, pa1, pa2, pa3); pv_read<3>(fb, vb); SBAR(); partialSM_part<2>(q0, q1, m_reg, mn, alpha, pmax, mnC); SBAR();
  pv_wait(fb); pv_mma(o[3], fb, pa0, pa1, pa2, pa3); SBAR(); partialSM_part<3>(q0, q1, m_reg, mn, alpha, pmax, mnC); SBAR();
}
DEV void attn_unit(const bf16* __restrict__ Qb, const bf16* __restrict__ Kh, const bf16* __restrict__ Vh, const bf16* __restrict__ Rh, bf16* __restrict__ Ob, int seq, char* lds, LAS unsigned char* ldsl, int tid_in) {
  int tid_ = tid_in; asm volatile("" : "+v"(tid_));
  const int tid = tid_, wid = __builtin_amdgcn_readfirstlane(tid >> 6), lane = tid & 63, r32 = lane & 31, hi = lane >> 5;
  float* ws = (float*)(lds + OFF_WS) + wid * 64; float* li_l = ws; float* al_l = ws + 32;
  if (wid >= 4) __builtin_amdgcn_s_setprio(1);
  float m_reg = -1e30f, l_reg = 0; f32x16 o[4] = {}; bf16x8 qr[12];
  const bf16* Qw = Qb + (long)(wid * QBLK + r32) * LDQ + hi * 8;
#pragma unroll
  for (int d0 = 0; d0 < 12; ++d0) qr[d0] = ld8(Qw + d0 * 16);
  const int vb0 = (int)(uintptr_t)(lds + OFF_V) + v_rd_base(lane);
  const int ka = (int)(uintptr_t)(lds + OFF_K) + r32 * 256 + ((hi * 16) ^ ((r32 & 15) << 4)), ra = (int)(uintptr_t)(lds + OFF_R) + r32 * 128 + ((hi * 16) ^ (((r32 >> 1) & 7) << 4));
  const int NT = seq / KVBLK;
#define DMA16(gp, lp) __builtin_amdgcn_global_load_lds((const unsigned*)(gp), (LAS unsigned*)(lp), 16, 0, 0)
#define DMA_SRC() const int ln_ = lane;   \
    int kof_[2], vof_[2]; _Pragma("unroll") for (int i = 0; i < 2; ++i) { const int n = 2 * wid + i; \
      { const int row = 4 * n + (ln_ >> 4), colB = ((ln_ & 15) * 16) ^ ((row & 15) << 4); kof_[i] = row * 256 + colB; } \
      { const int blk = 2 * n + (ln_ >> 5), kk = (blk >> 2) * 8 + ((ln_ & 31) >> 2), c = (blk & 3) * 32 + 8 * (ln_ & 3); vof_[i] = kk * 256 + c * 2;   } } \
    const int rrow_ = 8 * wid + (ln_ >> 3), rof_ = rrow_ * 128 + (((ln_ & 7) * 16) ^ (((rrow_ >> 1) & 7) << 4));
#define DMA_KR(t, b) do { const int tt = (t) < NT ? (t) : NT - 1; const char* kp = (const char*)Kh + (size_t)tt * (KVBLK * 256); const char* rp = (const char*)Rh + (size_t)tt * (KVBLK * 128); \
    DMA16(kp + kof_[0], ldsl + OFF_K + (b) * SHM_K + (2 * wid) * 1024); DMA16(kp + kof_[1], ldsl + OFF_K + (b) * SHM_K + (2 * wid + 1) * 1024); DMA16(rp + rof_, ldsl + OFF_R + (b) * SHM_R + wid * 1024); } while (0)
#define DMA_V(t, b) do { const int tt = (t) < NT ? (t) : NT - 1; const char* vp = (const char*)Vh + (size_t)tt * (KVBLK * 256); \
    DMA16(vp + vof_[0], ldsl + OFF_V + (b) * SHM_V + (2 * wid) * 1024); DMA16(vp + vof_[1], ldsl + OFF_V + (b) * SHM_V + (2 * wid + 1) * 1024); } while (0)
#define WAITV(n) asm volatile("s_waitcnt vmcnt(" #n ")" ::: "memory")
#define NEXTB(b) ((b) == NBUF - 1 ? 0 : (b) + 1)
#define RESC(a) do { if (__any((a) < 1.f)) { if (hi == 0) al_l[r32] = (a); asm volatile("s_waitcnt lgkmcnt(0)" ::: "memory"); \
    _Pragma("unroll") for (int d = 0; d < 4; ++d) _Pragma("unroll") for (int r = 0; r < 16; ++r) o[d][r] *= al_l[crow(r, hi)]; } } while (0)
  f32x16 pA0, pA1, pB0, pB1; float mnA, mnB, alA, alB; bf16x8 pa0, pa1, pa2, pa3;
  DMA_SRC();
  DMA_KR(0, 0); DMA_KR(1, 1); DMA_V(0, 0); DMA_KR(2, 2); DMA_V(1, 1);
  WAITV(10); __builtin_amdgcn_s_barrier(); asm volatile("" ::: "memory");
  qkt(pA0, pA1, ka, ra, 0, 0, qr); partialSM(pA0, pA1, m_reg, mnA, alA);
  int bt = 0;
#define HALF(t, X0, X1, alX, Y0, Y1, mnY, alY) do { \
    WAITV(5); __builtin_amdgcn_s_barrier(); asm volatile("" ::: "memory"); \
    const int b1 = NEXTB(bt), b2 = NEXTB(b1); \
    SBAR(); qkt_fin(Y0, Y1, ka, ra, b1 * SHM_K, b1 * SHM_R, qr, X0, X1, alX, l_reg, pa0, pa1, pa2, pa3); SBAR(); \
    DMA_KR((t) + 3, bt); DMA_V((t) + 2, b2); SBAR();        \
    pv_psm(o, vb0 + bt * SHM_V, pa0, pa1, pa2, pa3, Y0, Y1, m_reg, mnY, alY); \
    RESC(alY); bt = b1; } while (0)
  int t = 0;
  for (; t + 2 < NT; t += 2) {
    HALF(t, pA0, pA1, alA, pB0, pB1, mnB, alB);
    HALF(t + 1, pB0, pB1, alB, pA0, pA1, mnA, alA);
  }
  HALF(t, pA0, pA1, alA, pB0, pB1, mnB, alB);
  WAITV(0); __builtin_amdgcn_s_barrier(); asm volatile("" ::: "memory");
  finishSM(pB0, pB1, alB, l_reg, pa0, pa1, pa2, pa3); SBAR();
  pv_d0(o, vb0 + bt * SHM_V, pa0, pa1, pa2, pa3);
  if (hi == 0) li_l[r32] = l_reg; asm volatile("s_waitcnt lgkmcnt(0)" ::: "memory");
  float rli[16];
#pragma unroll
  for (int r = 0; r < 16; ++r) rli[r] = __builtin_amdgcn_rcpf(li_l[crow(r, hi)]);
  bf16* Ow = Ob + (long)(wid * QBLK) * LDO;
  LAS unsigned char* ot = ldsl + OFF_K + wid * 8192;
  { LAS unsigned char* ob = ot + hi * 1024 + r32 * 2;
#pragma unroll
    for (int r = 0; r < 16; ++r)
#pragma unroll
      for (int d0 = 0; d0 < 4; ++d0) *(LAS bf16*)(ob + ((r & 3) + 8 * (r >> 2)) * 256 + d0 * 64) = (bf16)f2bf(o[d0][r] * rli[r]); }
#pragma unroll
  for (int i = 0; i < 8; ++i) { const int c = i * 64 + lane, row = c >> 4, cc = c & 15;
    const u32x4 w = *(const LAS u32x4*)(ot + row * 256 + cc * 16); *(GAS u32x4*)(Ow + (long)row * LDO + cc * 8) = w; }
  __builtin_amdgcn_s_setprio(0);
  __syncthreads();
#undef DMA16
#undef DMA_SRC
#undef DMA_KR
#undef DMA_V
#undef WAITV
#undef NEXTB
#undef HALF
#undef RESC
}
#undef KSWZ
#undef RSWZ
}
#ifndef DBG_ML
#define DBG_ML 0
#endif
DEV f32x4 mfma16(bf16x8 a, bf16x8 b, f32x4 c) { return __builtin_amdgcn_mfma_f32_16x16x32_bf16(a, b, c, 0, 0, 0); }
DEV bf16x8 frag_row(const LAS unsigned char* T, int st, int row0, int k0, int lane) {
    return *(const LAS bf16x8*)(T + (row0 + (lane & 15)) * st + (k0 + 8 * (lane >> 4)) * 2);
}
DEV bf16x8 frag_tr(const LAS unsigned char* T, int st, int k0, int col0, int lane) {
    const int g = lane >> 4, q = (lane & 15) >> 2, p = lane & 3;
    const LAS unsigned char* a = T + (k0 + 8 * g + q) * st + (col0 + 4 * p) * 2;
    const s16x4 lo = __builtin_bit_cast(s16x4, __builtin_amdgcn_ds_read_tr16_b64_v4i16((LAS s16x4*)a));
    const s16x4 hi = __builtin_bit_cast(s16x4, __builtin_amdgcn_ds_read_tr16_b64_v4i16((LAS s16x4*)(a + 4 * st)));
    return (bf16x8){lo[0], lo[1], lo[2], lo[3], hi[0], hi[1], hi[2], hi[3]};
}
DEV bf16x8 frag_scale(bf16x8 a, float f) {
    const u32x4 w = __builtin_bit_cast(u32x4, a); u32x4 o;
    o.x = pk2(bflo(w.x) * f, bfhi(w.x) * f); o.y = pk2(bflo(w.y) * f, bfhi(w.y) * f); o.z = pk2(bflo(w.z) * f, bfhi(w.z) * f); o.w = pk2(bflo(w.w) * f, bfhi(w.w) * f);
    return __builtin_bit_cast(bf16x8, o);
}
DEV bf16x8 frag_scale8(bf16x8 a, f32x4 f0, f32x4 f1) {
    const u32x4 w = __builtin_bit_cast(u32x4, a); u32x4 o;
    o.x = pk2(bflo(w.x) * f0[0], bfhi(w.x) * f0[1]); o.y = pk2(bflo(w.y) * f0[2], bfhi(w.y) * f0[3]); o.z = pk2(bflo(w.z) * f1[0], bfhi(w.z) * f1[1]); o.w = pk2(bflo(w.w) * f1[2], bfhi(w.w) * f1[3]);
    return __builtin_bit_cast(bf16x8, o);
}
DEV bf16x8 frag_from_f32(const float* p) {
    const f32x4 a = *(const f32x4*)p, b = *(const f32x4*)(p + 4);
    u32x4 w; w.x = pk2(a[0], a[1]); w.y = pk2(a[2], a[3]); w.z = pk2(b[0], b[1]); w.w = pk2(b[2], b[3]); return __builtin_bit_cast(bf16x8, w);
}
template <bool MAXOP> DEV void wave_scan2(float x0, float x1, int lane, float& r0, float& r1, float& tot) {
    float s = MAXOP ? fmaxf(x0, x1) : x0 + x1;
#pragma unroll
    for (int o = 1; o < 64; o <<= 1) { const float t = shup(s, o, lane); if (lane >= o) s = MAXOP ? fmaxf(s, t) : s + t; }
    float e = shup(s, 1, lane); if (lane == 0) e = MAXOP ? -3.0e38f : 0.f;
    r0 = MAXOP ? fmaxf(e, x0) : e + x0; r1 = s; tot = __uint_as_float(__builtin_amdgcn_readlane(__float_as_uint(s), 63));
}

constexpr int ST128 = 272, ST256 = 528;

DEV void stage_tile(LAS unsigned char* T, int st, const bf16* g, size_t gst, int rows, int cols, float scale, int tid) {
    const int cpr = cols >> 3, n = rows * cpr;
    for (int i = tid; i < n; i += 512) { const int r = i / cpr, c = i - r * cpr; u32x4 w = *(const u32x4*)(g + (size_t)r * gst + c * 8);
        if (scale != 1.f) { float v[8]; unpack8(w, v);
#pragma unroll
            for (int e = 0; e < 8; ++e) v[e] *= scale; w = pack8(v); }
        *(LAS u32x4*)(T + r * st + c * 16) = w; }
}
template <int COLS> DEV void stage_conv(LAS unsigned char* T, int st, const bf16* zin_b  , int s0, int zcol0, int ch0, const float* cw, const float* cb, int tid) {
    constexpr int CPR = COLS / 8, RPT = 128 * CPR / 512;
    const int c = tid % CPR, r0 = (tid / CPR) * RPT;
    f32x4 w[5][2], bias[2];
#pragma unroll
    for (int j = 0; j < 5; ++j) { w[j][0] = *(const GAS f32x4*)(cw + j * 1536 + ch0 + c * 8); w[j][1] = *(const GAS f32x4*)(cw + j * 1536 + ch0 + c * 8 + 4); }
    bias[0] = *(const GAS f32x4*)(cb + ch0 + c * 8); bias[1] = *(const GAS f32x4*)(cb + ch0 + c * 8 + 4);
    u32x4 raw[RPT + 4];
#pragma unroll
    for (int k = 0; k < RPT + 4; ++k) { const int s = s0 + r0 + k - 2; raw[k] = (u32x4){0u, 0u, 0u, 0u};
        if (s >= 0 && s < SEQ) raw[k] = *(const GAS u32x4*)(zin_b + (size_t)s * ZW + zcol0 + c * 8); }
#pragma unroll
    for (int k = 0; k < RPT; ++k) { float acc[8];
#pragma unroll
        for (int e = 0; e < 4; ++e) { acc[e] = bias[0][e]; acc[4 + e] = bias[1][e]; }
#pragma unroll
        for (int j = 0; j < 5; ++j) { float v[8]; unpack8(raw[k + j], v);
#pragma unroll
            for (int e = 0; e < 4; ++e) { acc[e] += v[e] * w[j][0][e]; acc[4 + e] += v[4 + e] * w[j][1][e]; } }
#pragma unroll
        for (int e = 0; e < 8; ++e) acc[e] = siluf_(acc[e]);
        *(LAS u32x4*)(T + (r0 + k) * st + c * 16) = pack8(acc); }
}

DEV void mlstm_state_unit(const Params& P, const Ctx& C0, int L, int unit) {
    const Ctx C = fresh(C0);
    const int b = unit >> 8, h = (unit >> 6) & 3, ch = unit & 63, tid = C.tid, lane = C.lane, wave = C.wave, fq = lane >> 4;
    const size_t tok0 = (size_t)b * SEQ + ch * 128;
    const bf16* ZIN = (const bf16*)(C.ws + WS_ZIN); const float* SMALL = (const float*)(C.ws + WS_SMALL);
    float* misc = (float*)(C.ws + WS_MISC);
    LAS unsigned char* KS = C.lds; LAS unsigned char* VS = C.lds + 128 * ST128; LAS float* EE = (LAS float*)(C.lds + 128 * ST128 + 128 * ST256);
    if (wave < 2) { const int d = wave, idx = ((b * 4 + h) * 2 + d) * 64 + ch;
        const float big = P.in[I_BIG][L * 8 + d * 4 + h], bfg = P.in[I_BFG][L * 8 + d * 4 + h];
        const int j0 = 2 * lane, j1 = j0 + 1, i0 = d ? 127 - j0 : j0, i1 = d ? 127 - j1 : j1;
        const float li0 = SMALL[(tok0 + i0) * SMW + d * 4 + h] + big, li1 = SMALL[(tok0 + i1) * SMW + d * 4 + h] + big;
        const float lf0 = logsigf_(SMALL[(tok0 + i0) * SMW + 8 + d * 4 + h] + bfg), lf1 = logsigf_(SMALL[(tok0 + i1) * SMW + 8 + d * 4 + h] + bfg);
        float b0, b1, g; wave_scan2<false>(lf0, lf1, lane, b0, b1, g);
        const float w0 = g - b0 + li0, w1 = g - b1 + li1; const float m = wave_max(fmaxf(w0, w1), lane);
        EE[d * 128 + i0] = __expf(w0 - m); EE[d * 128 + i1] = __expf(w1 - m);
        if (lane == 0) { misc[OFF_MLOC / 4 + idx] = m; misc[OFF_MG / 4 + idx] = g; }
    }
    stage_tile(KS, ST128, ZIN + tok0 * ZW + ZC_AK + h * 128, ZW, 128, 128, 0.08838834764831845f, tid);
    stage_tile(VS, ST256, ZIN + tok0 * ZW + ZC_AV + h * 256, ZW, 128, 256, 1.f, tid);
    __syncthreads();
    {
        const int dk = tid >> 2, part = tid & 3; float s0 = 0.f, s1 = 0.f;
#pragma unroll 8
        for (int i = 0; i < 32; ++i) { const int r = part * 32 + i; const float kv = bf2f(*(const LAS unsigned short*)(KS + r * ST128 + dk * 2)); s0 += kv * EE[r]; s1 += kv * EE[128 + r]; }
        s0 += shx(s0, 1, lane); s0 += shx(s0, 2, lane); s1 += shx(s1, 1, lane); s1 += shx(s1, 2, lane);
        if (part == 0) { const int idx0 = ((b * 4 + h) * 2) * 64 + ch; misc[OFF_NLOC / 4 + (size_t)idx0 * 128 + dk] = s0; misc[OFF_NLOC / 4 + (size_t)(idx0 + 64) * 128 + dk] = s1; } }
    for (int d = 0; d < 2; ++d) {
        const int idx = ((b * 4 + h) * 2 + d) * 64 + ch;
        f32x4 acc[8][2];
#pragma unroll
        for (int a = 0; a < 8; ++a) { acc[a][0] = (f32x4){0.f, 0.f, 0.f, 0.f}; acc[a][1] = (f32x4){0.f, 0.f, 0.f, 0.f}; }
#pragma unroll 1
        for (int ks = 0; ks < 4; ++ks) { const bf16x8 bv0 = frag_tr(VS, ST256, 32 * ks, 32 * wave, lane), bv1 = frag_tr(VS, ST256, 32 * ks, 32 * wave + 16, lane);
            const f32x4 e0 = *(const LAS f32x4*)(EE + d * 128 + 32 * ks + 8 * fq), e1 = *(const LAS f32x4*)(EE + d * 128 + 32 * ks + 8 * fq + 4);
#pragma unroll
            for (int kt = 0; kt < 8; ++kt) { const bf16x8 a = frag_scale8(frag_tr(KS, ST128, 32 * ks, 16 * kt, lane), e0, e1); acc[kt][0] = mfma16(a, bv0, acc[kt][0]); acc[kt][1] = mfma16(a, bv1, acc[kt][1]); } }
        bf16* CL = (bf16*)(C.ws + WS_CLOC) + (size_t)idx * 32768;
#pragma unroll
        for (int kt = 0; kt < 8; ++kt)
#pragma unroll
            for (int nt = 0; nt < 2; ++nt) { u32x2 w; w.x = pk2(acc[kt][nt][0], acc[kt][nt][1]); w.y = pk2(acc[kt][nt][2], acc[kt][nt][3]);
                *(GAS u32x2*)(CL + (size_t)(32 * wave + 16 * nt + (lane & 15)) * 128 + 16 * kt + 4 * (lane >> 4)) = w; }
    }
    __syncthreads();
}

DEV void mlstm_scan(const Ctx& C0) {
    const Ctx C = fresh(C0);
    float* misc = (float*)(C.ws + WS_MISC); const float* MLOC = misc + OFF_MLOC / 4; const float* MG = misc + OFF_MG / 4; float* M0 = misc + OFF_M0 / 4; float* NL = misc + OFF_NLOC / 4;
    bf16* CL = (bf16*)(C.ws + WS_CLOC);
    const int nthreads = C.G * 512;
    for (int t = C.bid * 512 + C.tid; t < 16 * 8192; t += nthreads) {
        const int chain = t >> 13, e4 = t & 8191, d = chain & 1; const bool hasn = e4 < 32;
        f32x4 st = (f32x4){0.f, 0.f, 0.f, 0.f}, sn = (f32x4){0.f, 0.f, 0.f, 0.f}; float m = 0.f;
        bf16* base = CL + (size_t)chain * 64 * 32768 + e4 * 4; float* nbase = NL + (size_t)chain * 64 * 128 + (e4 & 31) * 4;
        for (int s8 = 0; s8 < 64; s8 += 16) { u32x2 x[16]; f32x4 xn[16];
#pragma unroll
            for (int k = 0; k < 16; ++k) { const int ch = d ? 63 - (s8 + k) : s8 + k; x[k] = *(const GAS u32x2*)(base + (size_t)ch * 32768);
                xn[k] = (f32x4){0.f, 0.f, 0.f, 0.f}; if (hasn) xn[k] = *(const GAS f32x4*)(nbase + (size_t)ch * 128); }
#pragma unroll
            for (int k = 0; k < 16; ++k) { const int ch = d ? 63 - (s8 + k) : s8 + k; const float g = MG[chain * 64 + ch], ml = MLOC[chain * 64 + ch];
                u32x2 w; w.x = pk2(st[0], st[1]); w.y = pk2(st[2], st[3]); *(GAS u32x2*)(base + (size_t)ch * 32768) = w;
                if (hasn) { *(GAS f32x4*)(nbase + (size_t)ch * 128) = sn; if (e4 == 0) M0[chain * 64 + ch] = m; }
                const float mn = fmaxf(g + m, ml), ap = __expf(g + m - mn), al = __expf(ml - mn);
                st = st * ap + (f32x4){bflo(x[k].x), bfhi(x[k].x), bflo(x[k].y), bfhi(x[k].y)} * al; sn = sn * ap + xn[k] * al; m = mn; } }
    }
}

DEV void mlstm_out_unit(const Params& P, const Ctx& C0, int L, int unit) {
    const Ctx C = fresh(C0);
    const int b = unit >> 8, h = (unit >> 6) & 3, ch = unit & 63, tid = C.tid, lane = C.lane, wave = C.wave, fr = lane & 15, fq = lane >> 4;
    const size_t tok0 = (size_t)b * SEQ + ch * 128;
    const bf16* ZIN = (const bf16*)(C.ws + WS_ZIN); const float* SMALL = (const float*)(C.ws + WS_SMALL); const float* misc = (const float*)(C.ws + WS_MISC);
    LAS unsigned char* QS = C.lds; LAS unsigned char* KP = C.lds + 128 * ST128; LAS unsigned char* VS = C.lds + 2 * 128 * ST128;
    LAS float* vec = (LAS float*)(C.lds + 2 * 128 * ST128 + 128 * ST256);
    LAS float* AVb = vec, *MXb = vec + 256, *EIb = vec + 512, *FLb = vec + 768, *QNb = vec + 1024, *FQ = vec + 1280, *SSQ = vec + 1408;
    if (wave < 2) {
        const int d = wave, idx = ((b * 4 + h) * 2 + d) * 64 + ch;
        const float big = P.in[I_BIG][L * 8 + d * 4 + h], bfg = P.in[I_BFG][L * 8 + d * 4 + h], m0 = misc[OFF_M0 / 4 + idx];
        const int j0 = 2 * lane, j1 = j0 + 1, i0 = d ? 127 - j0 : j0, i1 = d ? 127 - j1 : j1;
        const float li0 = SMALL[(tok0 + i0) * SMW + d * 4 + h] + big, li1 = SMALL[(tok0 + i1) * SMW + d * 4 + h] + big;
        const float lf0 = logsigf_(SMALL[(tok0 + i0) * SMW + 8 + d * 4 + h] + bfg), lf1 = logsigf_(SMALL[(tok0 + i1) * SMW + 8 + d * 4 + h] + bfg);
        float b0, b1, g; wave_scan2<false>(lf0, lf1, lane, b0, b1, g);
        const float a0 = li0 - b0, a1 = li1 - b1; float p0, p1, pt; wave_scan2<true>(a0, a1, lane, p0, p1, pt);
        const float x0 = fmaxf(m0, p0), x1 = fmaxf(m0, p1);
        LAS float* AV = AVb + d * 128, *MX = MXb + d * 128, *EI = EIb + d * 128, *FL = FLb + d * 128;
        AV[i0] = a0; AV[i1] = a1; MX[i0] = x0; MX[i1] = x1; EI[i0] = __expf(m0 - x0); EI[i1] = __expf(m0 - x1); FL[i0] = __expf(-(b0 + x0)); FL[i1] = __expf(-(b1 + x1));
    }
    stage_tile(QS, ST128, ZIN + tok0 * ZW + ZC_AQ + h * 128, ZW, 128, 128, 1.f, tid);
    stage_tile(KP, ST128, ZIN + tok0 * ZW + ZC_AK + h * 128, ZW, 128, 128, 0.08838834764831845f, tid);
    stage_tile(VS, ST256, ZIN + tok0 * ZW + ZC_AV + h * 256, ZW, 128, 256, 1.f, tid);
    __syncthreads();
    f32x4 sreg[8];
#pragma unroll
    for (int st = 0; st < 8; ++st) sreg[st] = (f32x4){0.f, 0.f, 0.f, 0.f};
#pragma unroll
    for (int ks = 0; ks < 4; ++ks) { const bf16x8 bq = frag_row(QS, ST128, 16 * wave, 32 * ks, lane);
#pragma unroll
        for (int st = 0; st < 8; ++st) sreg[st] = mfma16(frag_row(KP, ST128, 16 * st, 32 * ks, lane), bq, sreg[st]); }
#pragma unroll
    for (int d = 0; d < 2; ++d) {
        const int idx = ((b * 4 + h) * 2 + d) * 64 + ch, r = tid >> 2, part = tid & 3; const float* n0 = misc + OFF_NLOC / 4 + (size_t)idx * 128 + part * 32; float s = 0.f;
#pragma unroll
        for (int c = 0; c < 4; ++c) { float v[8]; unpack8(*(const LAS u32x4*)(QS + r * ST128 + (part * 32 + c * 8) * 2), v);
            const f32x4 n0a = *(const GAS f32x4*)(n0 + c * 8), n0b = *(const GAS f32x4*)(n0 + c * 8 + 4);
#pragma unroll
            for (int e = 0; e < 4; ++e) s += v[e] * n0a[e] + v[4 + e] * n0b[e]; }
        s += shx(s, 1, lane); s += shx(s, 2, lane); if (part == 0) QNb[d * 128 + r] = s;
    }
    f32x4 acc[8][2];
#pragma unroll
    for (int a = 0; a < 8; ++a) { acc[a][0] = (f32x4){0.f, 0.f, 0.f, 0.f}; acc[a][1] = (f32x4){0.f, 0.f, 0.f, 0.f}; }
    const int t = 16 * wave + fr;
    for (int d = 0; d < 2; ++d) {
        const int idx = ((b * 4 + h) * 2 + d) * 64 + ch;
        const LAS float* AV = AVb + d * 128; const LAS float* MX = MXb + d * 128; const LAS float* EI = EIb + d * 128; const LAS float* FL = FLb + d * 128; const LAS float* QN = QNb + d * 128;
        const bf16* C0 = (const bf16*)(C.ws + WS_CLOC) + (size_t)idx * 32768;
        bf16x8 bc[4][2];
#pragma unroll
        for (int ks = 0; ks < 4; ++ks)
#pragma unroll
            for (int nt = 0; nt < 2; ++nt) bc[ks][nt] = *(const GAS bf16x8*)(C0 + (size_t)(32 * wave + 16 * nt + fr) * 128 + 32 * ks + 8 * fq);
        __syncthreads();
        {
            const float mx = MX[t]; float rs = 0.f; f32x4 pr[8];
#pragma unroll
            for (int st = 0; st < 8; ++st) { const f32x4 av = *(const LAS f32x4*)(AV + 16 * st + 4 * fq);
#pragma unroll
                for (int i = 0; i < 4; ++i) { const int s = 16 * st + 4 * fq + i; const bool valid = d ? (s >= t) : (s <= t);
                    const float dd = valid ? __expf(av[i] - mx) : 0.f; pr[st][i] = sreg[st][i] * dd; rs += pr[st][i]; } }
            rs = xsum32(xsum16(rs));
            const float den = rs + EI[t] * QN[t]; const float inv = __builtin_amdgcn_rcpf(fmaxf(fabsf(den), FL[t]));
            if (fq == 0) FQ[t] = EI[t] * inv;
#pragma unroll
            for (int st = 0; st < 8; ++st) { u32x2 w; w.x = pk2(pr[st][0] * inv, pr[st][1] * inv); w.y = pk2(pr[st][2] * inv, pr[st][3] * inv);
                *(LAS u32x2*)(KP + t * ST128 + (16 * st + 4 * fq) * 2) = w; }
        }
        __syncthreads();
#pragma unroll 1
        for (int ks = 0; ks < 4; ++ks) { const bf16x8 bv0 = frag_tr(VS, ST256, 32 * ks, 32 * wave, lane), bv1 = frag_tr(VS, ST256, 32 * ks, 32 * wave + 16, lane);
#pragma unroll
            for (int tt = 0; tt < 8; ++tt) { const bf16x8 a = frag_row(KP, ST128, 16 * tt, 32 * ks, lane); if (!(DBG_ML & 1) && !((DBG_ML >> (2 + d)) & 1)) { acc[tt][0] = mfma16(a, bv0, acc[tt][0]); acc[tt][1] = mfma16(a, bv1, acc[tt][1]); } } }
#pragma unroll
        for (int ks = 0; ks < 4; ++ks) {
#pragma unroll
            for (int tt = 0; tt < 8; ++tt) { const bf16x8 a = frag_scale(frag_row(QS, ST128, 16 * tt, 32 * ks, lane), FQ[16 * tt + fr]); if (!(DBG_ML & 2) && !((DBG_ML >> (2 + d)) & 1)) { acc[tt][0] = mfma16(a, bc[ks][0], acc[tt][0]); acc[tt][1] = mfma16(a, bc[ks][1], acc[tt][1]); }
                if (tt & 1) __builtin_amdgcn_sched_barrier(0); } }
    }
#pragma unroll
    for (int tt = 0; tt < 8; ++tt)
#pragma unroll
        for (int i = 0; i < 4; ++i) { float s = acc[tt][0][i] * acc[tt][0][i] + acc[tt][1][i] * acc[tt][1][i];
            s += shx(s, 1, lane); s += shx(s, 2, lane); s += shx(s, 4, lane); s += shx(s, 8, lane);
            if (fr == 0) SSQ[wave * 128 + 16 * tt + 4 * fq + i] = s; }
    __syncthreads();
    if (tid < 128) { float s = 0.f;
#pragma unroll
        for (int w = 0; w < 8; ++w) s += SSQ[w * 128 + tid];
        FQ[tid] = rsqrtf(s * (1.f / 256.f) + EPS); }
    __syncthreads();
#pragma unroll
    for (int tt = 0; tt < 8; ++tt)
#pragma unroll
        for (int i = 0; i < 4; ++i) { const int tr = 16 * tt + 4 * fq + i; const float rstd = FQ[tr];
#pragma unroll
            for (int nt = 0; nt < 2; ++nt) *(LAS unsigned short*)(VS + tr * ST256 + (32 * wave + 16 * nt + fr) * 2) = (unsigned short)f2bf(acc[tt][nt][i] * rstd); }
    __syncthreads();
    {   const float* ng = P.in[I_MLN] + L * 1024 + h * 256; bf16* YA = (bf16*)(C.ws + WS_Y);
        u32x4 og[8];
#pragma unroll
        for (int k = 0; k < 8; ++k) { const int c = tid + 512 * k, tr = c >> 5, c8 = (c & 31) * 8; og[k] = *(const GAS u32x4*)(ZIN + (tok0 + tr) * ZW + ZC_AO + h * 256 + c8); }
#pragma unroll
        for (int k = 0; k < 8; ++k) { const int c = tid + 512 * k, tr = c >> 5, c8 = (c & 31) * 8; float hv[8], gv[8], o[8];
            unpack8(*(const LAS u32x4*)(VS + tr * ST256 + c8 * 2), hv); unpack8(og[k], gv);
            const f32x4 n0 = *(const GAS f32x4*)(ng + c8), n1 = *(const GAS f32x4*)(ng + c8 + 4);
#pragma unroll
            for (int e = 0; e < 4; ++e) { o[e] = sigmoidf_(gv[e]) * hv[e] * n0[e]; o[4 + e] = sigmoidf_(gv[4 + e]) * hv[4 + e] * n1[e]; }
            *(GAS u32x4*)(YA + (tok0 + tr) * 1024 + h * 256 + c8) = pack8(o); }
    }
    __syncthreads();
}
#ifndef DBG_SSD
#define DBG_SSD 0
#endif
DEV void ssd_vectors(const Params& P, const float* SMALL, size_t tok0, int L, int d, int hd, int lane, float& dt0, float& dt1, float& ac0, float& ac1, float& gt, int& i0, int& i1) {
    const float dtb = P.in[I_DTB][L * 32 + d * 16 + hd], A = -__expf(P.in[I_ALOG][L * 32 + d * 16 + hd]);
    const int j0 = 2 * lane, j1 = j0 + 1; i0 = d ? 127 - j0 : j0; i1 = d ? 127 - j1 : j1;
    dt0 = softplusf_(SMALL[(tok0 + i0) * SMW + 16 + d * 16 + hd] + dtb); dt1 = softplusf_(SMALL[(tok0 + i1) * SMW + 16 + d * 16 + hd] + dtb);
    wave_scan2<false>(dt0 * A, dt1 * A, lane, ac0, ac1, gt);
}
DEV void ssd_state_unit(const Params& P, const Ctx& C0, int L, int unit) {
    const Ctx C = fresh(C0);
    const int half = unit & 1, g = (unit >> 1) & 1, ch = (unit >> 2) & 63, b = unit >> 8, tid = C.tid, lane = C.lane, wave = C.wave, fr = lane & 15, fq = lane >> 4;
    const size_t tok0 = (size_t)b * SEQ + ch * 128;
    const bf16* ZINb = (const bf16*)(C.ws + WS_ZIN) + (size_t)b * SEQ * ZW; const float* SMALL = (const float*)(C.ws + WS_SMALL); float* misc = (float*)(C.ws + WS_MISC);
    const float* cw = P.in[I_CONVW] + (size_t)L * 5 * 1536; const float* cb = P.in[I_CONVB] + L * 1536;
    LAS unsigned char* BMs = C.lds; LAS unsigned char* XS = C.lds + 128 * ST128; LAS float* WG = (LAS float*)(C.lds + 128 * ST128 + 128 * ST256);
    const int hl = wave & 3, d = wave >> 2, hd = 8 * g + 4 * half + hl;
    {   float dt0, dt1, a0, a1, gt; int i0, i1; ssd_vectors(P, SMALL, tok0, L, d, hd, lane, dt0, dt1, a0, a1, gt, i0, i1);
        WG[wave * 128 + i0] = dt0 * __expf(gt - a0); WG[wave * 128 + i1] = dt1 * __expf(gt - a1);
        if (lane == 0) misc[OFF_SDEC / 4 + ((b * 2 + d) * 64 + ch) * 16 + hd] = __expf(gt); }
    stage_conv<128>(BMs, ST128, ZINb, ch * 128, ZC_XBC + 1024 + 128 * g, 1024 + 128 * g, cw, cb, tid);
    stage_conv<256>(XS, ST256, ZINb, ch * 128, ZC_XBC + 512 * g + 256 * half, 512 * g + 256 * half, cw, cb, tid);
    __syncthreads();
    bf16* SST = (bf16*)(C.ws + WS_SST) + (size_t)(((b * 2 + d) * 64 + ch) * 16 + hd) * 8192;
    for (int nh = 0; nh < 2; ++nh) {
        f32x4 acc[4][4];
#pragma unroll
        for (int a = 0; a < 4; ++a)
#pragma unroll
            for (int c = 0; c < 4; ++c) acc[a][c] = (f32x4){0.f, 0.f, 0.f, 0.f};
#pragma unroll
        for (int ks = 0; ks < 4; ++ks) {
            const f32x4 w0 = *(const LAS f32x4*)(WG + wave * 128 + 32 * ks + 8 * fq), w1 = *(const LAS f32x4*)(WG + wave * 128 + 32 * ks + 8 * fq + 4);
            bf16x8 bx[4];
#pragma unroll
            for (int pt = 0; pt < 4; ++pt) bx[pt] = frag_scale8(frag_tr(XS, ST256, 32 * ks, hl * 64 + 16 * pt, lane), w0, w1);
#pragma unroll
            for (int nt = 0; nt < 4; ++nt) { const bf16x8 a = frag_tr(BMs, ST128, 32 * ks, 64 * nh + 16 * nt, lane);
#pragma unroll
                for (int pt = 0; pt < 4; ++pt) acc[nt][pt] = mfma16(a, bx[pt], acc[nt][pt]); } }
#pragma unroll
        for (int nt = 0; nt < 4; ++nt)
#pragma unroll
            for (int pt = 0; pt < 4; ++pt) { u32x2 w; w.x = pk2(acc[nt][pt][0], acc[nt][pt][1]); w.y = pk2(acc[nt][pt][2], acc[nt][pt][3]);
                *(GAS u32x2*)(SST + (size_t)(16 * pt + fr) * 128 + 64 * nh + 16 * nt + 4 * fq) = w; }
    }
    __syncthreads();
}
DEV void ssd_scan(const Ctx& C0) {
    const Ctx C = fresh(C0);
    const float* SDEC = (const float*)(C.ws + WS_MISC) + OFF_SDEC / 4; bf16* SST = (bf16*)(C.ws + WS_SST);
    const int nthreads = C.G * 512;
    for (int t = C.bid * 512 + C.tid; t < 64 * 2048; t += nthreads) {
        const int e4 = t & 2047, hd = (t >> 11) & 15, bd = t >> 15, d = bd & 1;
        bf16* base = SST + (size_t)(bd * 64 * 16 + hd) * 8192 + e4 * 4; const size_t cst = (size_t)16 * 8192;
        f32x4 st = (f32x4){0.f, 0.f, 0.f, 0.f};
        for (int s8 = 0; s8 < 64; s8 += 16) { u32x2 x[16];
#pragma unroll
            for (int k = 0; k < 16; ++k) { const int ch = d ? 63 - (s8 + k) : s8 + k; x[k] = *(const GAS u32x2*)(base + (size_t)ch * cst); }
#pragma unroll
            for (int k = 0; k < 16; ++k) { const int ch = d ? 63 - (s8 + k) : s8 + k; const float dc = SDEC[(bd * 64 + ch) * 16 + hd];
                u32x2 w; w.x = pk2(st[0], st[1]); w.y = pk2(st[2], st[3]); *(GAS u32x2*)(base + (size_t)ch * cst) = w;
                st = st * dc + (f32x4){bflo(x[k].x), bfhi(x[k].x), bflo(x[k].y), bfhi(x[k].y)}; } }
    }
}
DEV void ssd_out_unit(const Params& P, const Ctx& C0, int L, int unit) {
    const Ctx C = fresh(C0);
    const int half = unit & 1, g = (unit >> 1) & 1, ch = (unit >> 2) & 63, b = unit >> 8, tid = C.tid, lane = C.lane, wave = C.wave, fr = lane & 15, fq = lane >> 4;
    const size_t tok0 = (size_t)b * SEQ + ch * 128;
    const bf16* ZIN = (const bf16*)(C.ws + WS_ZIN); const bf16* ZINb = ZIN + (size_t)b * SEQ * ZW; const float* SMALL = (const float*)(C.ws + WS_SMALL);
    const float* cw = P.in[I_CONVW] + (size_t)L * 5 * 1536; const float* cb = P.in[I_CONVB] + L * 1536;
    LAS unsigned char* CMs = C.lds; LAS unsigned char* BC = C.lds + 128 * ST128; LAS unsigned char* XS = C.lds + 2 * 128 * ST128;
    LAS float* DT = (LAS float*)(C.lds + 2 * 128 * ST128 + 128 * ST256); LAS float* ACS = DT + 8 * 128;
    {   const int hl = wave & 3, d = wave >> 2, hd = 8 * g + 4 * half + hl;
        float dt0, dt1, a0, a1, gt; int i0, i1; ssd_vectors(P, SMALL, tok0, L, d, hd, lane, dt0, dt1, a0, a1, gt, i0, i1);
        DT[wave * 128 + i0] = dt0; DT[wave * 128 + i1] = dt1; ACS[wave * 128 + i0] = a0; ACS[wave * 128 + i1] = a1; }
    stage_conv<128>(CMs, ST128, ZINb, ch * 128, ZC_XBC + 1280 + 128 * g, 1280 + 128 * g, cw, cb, tid);
    stage_conv<128>(BC, ST128, ZINb, ch * 128, ZC_XBC + 1024 + 128 * g, 1024 + 128 * g, cw, cb, tid);
    stage_conv<256>(XS, ST256, ZINb, ch * 128, ZC_XBC + 512 * g + 256 * half, 512 * g + 256 * half, cw, cb, tid);
    __syncthreads();
    {
        f32x4 cbr[8];
#pragma unroll
        for (int st = 0; st < 8; ++st) cbr[st] = (f32x4){0.f, 0.f, 0.f, 0.f};
#pragma unroll
        for (int ks = 0; ks < 4; ++ks) { const bf16x8 bc = frag_row(CMs, ST128, 16 * wave, 32 * ks, lane);
#pragma unroll
            for (int st = 0; st < 8; ++st) cbr[st] = mfma16(frag_row(BC, ST128, 16 * st, 32 * ks, lane), bc, cbr[st]); }
        __syncthreads();
        const int t = 16 * wave + fr;
#pragma unroll
        for (int st = 0; st < 8; ++st) { u32x2 w; w.x = pk2(cbr[st][0], cbr[st][1]); w.y = pk2(cbr[st][2], cbr[st][3]); *(LAS u32x2*)(BC + t * ST128 + (16 * st + 4 * fq) * 2) = w; }
    }
    __syncthreads();
    const int hl = wave & 3, th = wave >> 2, hd = 8 * g + 4 * half + hl;
    f32x4 acc[4][4];
#pragma unroll
    for (int a = 0; a < 4; ++a)
#pragma unroll
        for (int c = 0; c < 4; ++c) acc[a][c] = (f32x4){0.f, 0.f, 0.f, 0.f};
    for (int d = 0; d < 2; ++d) {
        const LAS float* dtv = DT + (hl + 4 * d) * 128; const LAS float* acv = ACS + (hl + 4 * d) * 128;
        const bf16* S0 = (const bf16*)(C.ws + WS_SST) + (size_t)(((b * 2 + d) * 64 + ch) * 16 + hd) * 8192;
        bf16x8 bs[4][4];
#pragma unroll
        for (int ks = 0; ks < 4; ++ks)
#pragma unroll
            for (int pt = 0; pt < 4; ++pt) bs[ks][pt] = *(const GAS bf16x8*)(S0 + (size_t)(16 * pt + fr) * 128 + 32 * ks + 8 * fq);
#pragma unroll 1
        for (int ks = 0; ks < 4; ++ks) {
            bf16x8 bx[4];
#pragma unroll
            for (int pt = 0; pt < 4; ++pt) bx[pt] = frag_tr(XS, ST256, 32 * ks, hl * 64 + 16 * pt, lane);
            const int s0 = 32 * ks + 8 * fq;
            const f32x4 as0 = *(const LAS f32x4*)(acv + s0), as1 = *(const LAS f32x4*)(acv + s0 + 4), ds0 = *(const LAS f32x4*)(dtv + s0), ds1 = *(const LAS f32x4*)(dtv + s0 + 4);
#pragma unroll
            for (int tt = 0; tt < 4; ++tt) { const int t = 64 * th + 16 * tt + fr; const float at = acv[t];
                const bf16x8 cbf = frag_row(BC, ST128, 64 * th + 16 * tt, 32 * ks, lane); f32x4 l0, l1;
#pragma unroll
                for (int e = 0; e < 4; ++e) { const int sa = s0 + e, sb = s0 + 4 + e; const bool va = d ? (sa >= t) : (sa <= t), vb = d ? (sb >= t) : (sb <= t);
                    l0[e] = va ? __expf(at - as0[e]) * ds0[e] : 0.f; l1[e] = vb ? __expf(at - as1[e]) * ds1[e] : 0.f; }
                const bf16x8 a = frag_scale8(cbf, l0, l1);
#pragma unroll
                for (int pt = 0; pt < 4; ++pt) if (!((DBG_SSD >> 0) & 1) && !((DBG_SSD >> (2 + d)) & 1)) acc[tt][pt] = mfma16(a, bx[pt], acc[tt][pt]); } }
#pragma unroll
        for (int ks = 0; ks < 4; ++ks) {
#pragma unroll
            for (int tt = 0; tt < 4; ++tt) { const int t = 64 * th + 16 * tt + fr;
                const bf16x8 a = frag_scale(frag_row(CMs, ST128, 64 * th + 16 * tt, 32 * ks, lane), __expf(acv[t]));
#pragma unroll
                for (int pt = 0; pt < 4; ++pt) if (!((DBG_SSD >> 1) & 1) && !((DBG_SSD >> (2 + d)) & 1)) acc[tt][pt] = mfma16(a, bs[ks][pt], acc[tt][pt]);
                __builtin_amdgcn_sched_barrier(0); } }
    }
    __syncthreads();
    LAS unsigned char* YT = C.lds;
#pragma unroll
    for (int tt = 0; tt < 4; ++tt)
#pragma unroll
        for (int i = 0; i < 4; ++i) { const int t = 64 * th + 16 * tt + 4 * fq + i;
#pragma unroll
            for (int pt = 0; pt < 4; ++pt) *(LAS unsigned short*)(YT + t * ST256 + (hl * 64 + 16 * pt + fr) * 2) = (unsigned short)f2bf(acc[tt][pt][i]); }
    __syncthreads();
    {   bf16* YB = (bf16*)(C.ws + WS_Y) + (size_t)M * 1024; u64* ybss = (u64*)(C.ws + OFF_YBSS) + (size_t)L * M; const int ch0 = 512 * g + 256 * half;
        u32x4 zq[8];
#pragma unroll
        for (int k = 0; k < 8; ++k) { const int c = tid + 512 * k, t = c >> 5, c8 = (c & 31) * 8; zq[k] = *(const GAS u32x4*)(ZIN + (tok0 + t) * ZW + ZC_BZ + ch0 + c8); }
#pragma unroll
        for (int k = 0; k < 8; ++k) { const int c = tid + 512 * k, t = c >> 5, c8 = (c & 31) * 8; float yv[8], xv[8], zv[8], o[8];
            const float dsk = P.in[I_SSD][L * 16 + 8 * g + 4 * half + (c8 >> 6)];
            unpack8(*(const LAS u32x4*)(YT + t * ST256 + c8 * 2), yv); unpack8(*(const LAS u32x4*)(XS + t * ST256 + c8 * 2), xv); unpack8(zq[k], zv);
            float part = 0.f;
#pragma unroll
            for (int e = 0; e < 8; ++e) { o[e] = (yv[e] + dsk * xv[e]) * siluf_(zv[e]); part += o[e] * o[e]; }
            *(GAS u32x4*)(YB + (tok0 + t) * 1024 + ch0 + c8) = pack8(o);
            part += shx(part, 1, lane); part += shx(part, 2, lane); part += shx(part, 4, lane); part += shx(part, 8, lane); part += shx(part, 16, lane);
            if ((lane & 31) == 0) ss_add(ybss + tok0 + t, part); }
    }
    __syncthreads();
}

DEV void krope_phase(const Ctx& C0) {
    const Ctx C = fresh(C0);
    const float* SMALL = (const float*)(C.ws + WS_SMALL); const float* COS = (const float*)(C.ws + WS_COS); const float* SIN = (const float*)(C.ws + WS_SIN); bf16* KR = (bf16*)(C.ws + WS_KR);
    for (int i = C.bid * 512 + C.tid; i < M * 32; i += C.G * 512) { const int m = i >> 5, j = i & 31;
        const float t1 = SMALL[(size_t)m * SMW + 48 + j], t2 = SMALL[(size_t)m * SMW + 80 + j], cs = COS[i], sn = SIN[i];
        KR[(size_t)m * 64 + j] = (bf16)f2bf(t1 * cs - t2 * sn); KR[(size_t)m * 64 + 32 + j] = (bf16)f2bf(t2 * cs + t1 * sn); }
}
DEV void final_phase(const Params& P, const Ctx& C0) {
    const Ctx C = fresh(C0);
    const bf16* HB = (const bf16*)(C.ws + WS_HB0); const u64* hss = (const u64*)(C.ws + OFF_HSS) + (size_t)16 * M; const float* gn = P.in[I_FIN];
    for (size_t i = (size_t)C.bid * 512 + C.tid; i < (size_t)M * DM / 8; i += (size_t)C.G * 512) { const int m = (int)(i >> 8), c = (int)(i & 255) * 8;
        const float rs = ss_to_rstd(hss[m], 1.f / DM); float h[8]; unpack8(*(const GAS u32x4*)(HB + i * 8), h);
        const f32x4 g0 = *(const f32x4*)(gn + c), g1 = *(const f32x4*)(gn + c + 4);
        *(GAS f32x4*)(P.out + i * 8) = (f32x4){h[0] * rs * g0[0], h[1] * rs * g0[1], h[2] * rs * g0[2], h[3] * rs * g0[3]};
        *(GAS f32x4*)(P.out + i * 8 + 4) = (f32x4){h[4] * rs * g1[0], h[5] * rs * g1[1], h[6] * rs * g1[2], h[7] * rs * g1[3]}; }
}
#ifndef MK_MODE
#define MK_MODE 0
#endif
constexpr int NPHASE = 12;

__global__ void __launch_bounds__(512, 2) mk_fwd(Params P) {
    extern __shared__ __attribute__((aligned(16))) unsigned char lds[];
    Ctx CK; CK.lds = (LAS unsigned char*)lds; CK.ws = P.ws; CK.tid = threadIdx.x; CK.lane = CK.tid & 63; CK.wave = __builtin_amdgcn_readfirstlane(CK.tid >> 6); CK.G = gridDim.x; CK.bid = blockIdx.x;
    volatile LAS unsigned* MISC = (volatile LAS unsigned*)(CK.lds + LDS_MISC);
    if (CK.tid < 64) MISC[CK.tid] = 0u;
    __syncthreads();
    XcdBarrier bar; bar.bar = (unsigned*)(P.ws + WS_CTL) + CW_BAR; bar.x = 0; bar.st = nullptr;
    if (P.use_bar) bar = xcd_barrier_post((unsigned*)(P.ws + WS_CTL) + CW_BAR, MISC + 8);
#define SEAM() do { if (P.use_bar) xcd_barrier(bar); } while (0)
#ifndef MK_DUP
#define MK_DUP 0
#endif
#define REP(k) for (int rep_ = 0; rep_ < (((MK_DUP >> (k)) & 1) ? 2 : 1); ++rep_)
#ifndef MK_SUB
#define MK_SUB 0xFFFF
#endif
#define SUB(k) ((MK_SUB >> (k)) & 1)
#ifndef MK_MASK
#define MK_MASK 0xFFFF
#endif
#define IN(k) (((MK_MASK >> (k)) & 1) && P.ph_lo <= (k) && (k) < P.ph_hi)
#define WSP(T, off) ((T*)(C.ws + (off)))
#define WB WSP(bf16, WS_W)
#define H WSP(float, WS_H)
#define HB0 WSP(bf16, WS_HB0)
#define HB1 WSP(bf16, WS_HB1)
#define ZIN WSP(bf16, WS_ZIN)
#define U WSP(bf16, WS_U)
#define SMALL WSP(float, WS_SMALL)
#define Q WSP(bf16, WS_Q)
#define KN WSP(bf16, WS_KN)
#define V WSP(bf16, WS_V)
#define KR WSP(bf16, WS_KR)
#define PP WSP(bf16, WS_PP)
#define PB WSP(bf16, WS_PB)
#define COS WSP(float, WS_COS)
#define SIN WSP(float, WS_SIN)
#define MERGE WSP(float, WS_MERGE)
#define MERGEB WSP(bf16, WS_MERGEB)
#define Y WSP(bf16, WS_Y)
#define HSS WSP(u64, OFF_HSS)
#define CQSS WSP(u64, OFF_CQSS)
#define CKVSS WSP(u64, OFF_CKVSS)
#define YBSS WSP(u64, OFF_YBSS)
    if (P.l_lo == 0 && P.l_hi > 0 && IN(0)) rope_tables(P, CK);
    for (int L = P.l_lo; L < P.l_hi; ++L) {
        if (IN(0)) REP(0) { const Ctx C = fresh(CK); phase_convert(P, C, L); SEAM(); }
        if (IN(1)) REP(1) { const Ctx C = fresh(CK);
            pg8::Gemm g{HB0, WB + WE_13A, DM, DM, DM}; pg8::StaticOrder S; S.init(M, 2 * FF, C.G, C.bid);
            EpiSwiGLU E{HSS + (size_t)(4 * L) * M, U};
            pg8::gemm_phase<EpiSwiGLU, pg8::StaticOrder, true>(C.lds, g, S, E, C.tid); SEAM(); }
        if (IN(2)) { const Ctx C = fresh(CK);
            pg8::Gemm g{U, WB + WE_2A, FF, FF, FF}; pg8::StaticOrder S; S.init(M, DM, C.G, C.bid);
            EpiResid<0> E{HB0, HB1, HSS + (size_t)(4 * L + 1) * M, 0.5f, nullptr, nullptr};
            pg8::gemm_phase<EpiResid<0>, pg8::StaticOrder, true>(C.lds, g, S, E, C.tid); SEAM(); }
        if (IN(3)) { const Ctx C = fresh(CK);
            pg8::Gemm g{HB1, WB + WE_IN, DM, DM, DM}; pg8::StaticOrder S; S.init(M, WIN_ROWS, C.G, C.bid);
            EpiWin E{HSS + (size_t)(4 * L + 1) * M, ZIN, SMALL, CQSS + (size_t)L * M, CKVSS + (size_t)L * M};
            pg8::gemm_phase<EpiWin, pg8::StaticOrder, true>(C.lds, g, S, E, C.tid); SEAM(); }
        if (IN(4)) REP(4) { const Ctx C = fresh(CK);
            if (SUB(2)) { pg8::Gemm g{ZIN + ZC_CQ, WB + WE_UQ, ZW, 512, 512}; pg8::StaticOrder S; S.init(M, 1536, C.G, C.bid);
              EpiQup E{CQSS + (size_t)L * M, Q, COS, SIN}; pg8::gemm_phase<EpiQup, pg8::StaticOrder, true>(C.lds, g, S, E, C.tid); }
            if (SUB(3)) { pg8::Gemm g{ZIN + ZC_CKV, WB + WE_UKV, ZW, 512, 512}; pg8::StaticOrder S; S.init(M, 2048, C.G, C.bid);
              EpiKVup E{CKVSS + (size_t)L * M, KN, V}; pg8::gemm_phase<EpiKVup, pg8::StaticOrder, true>(C.lds, g, S, E, C.tid); }
            krope_phase(C);
            if (SUB(0)) for (int u = C.bid; u < 512; u += C.G) mlstm_state_unit(P, C, L, u);
            if (SUB(1)) for (int u = C.bid; u < 512; u += C.G) ssd_state_unit(P, C, L, u);
            SEAM(); }
        if (IN(5)) { const Ctx C = fresh(CK);
            if (SUB(7)) { mlstm_scan(C); ssd_scan(C); }
            if (SUB(6)) REP(13) for (int i = 0; i < 512; i += C.G) { int bh, qb;
                if (C.G == 256) { bh = (C.bid & 7) + 8 * (i >> 8); qb = C.bid >> 3; } else { const int u = i + C.bid; if (u >= 512) break; bh = u >> 5; qb = u & 31; }
                const int b = bh >> 3, h = bh & 7;
                att::attn_unit(Q + ((size_t)bh * SEQ + qb * 256) * 192, KN + (size_t)bh * SEQ * 128, V + (size_t)bh * SEQ * 128, KR + (size_t)b * SEQ * 64,
                               Y + (size_t)2 * M * 1024 + ((size_t)b * SEQ + qb * 256) * 1024 + h * 128, SEQ, (char*)lds, CK.lds, fresh(CK).tid); }
            SEAM(); }
        if (IN(6)) { const Ctx C = fresh(CK);
            if (SUB(4)) REP(14) for (int u = C.bid; u < 512; u += C.G) mlstm_out_unit(P, C, L, u);
            if (SUB(5)) for (int u = C.bid; u < 512; u += C.G) ssd_out_unit(P, C, L, u);
            SEAM(); }
        if (IN(7)) REP(7) { const Ctx C = fresh(CK);
            if (SUB(8)) { pg8::Gemm g{Y, WB + WE_BR, 1024, 1024, 1024}; pg8::BranchOrder S{C.G, C.bid};
              EpiBranch E{ZIN, YBSS + (size_t)L * M, MERGEB}; pg8::gemm_phase<EpiBranch, pg8::BranchOrder, true>(C.lds, g, S, E, C.tid); }
            if (SUB(9)) { pg8::Gemm g{PB, WB + WE_PP, PLE, PLE, PLE}; pg8::StaticOrder S; S.init(M, DM, C.G, C.bid);
              EpiPlain E{PP, DM}; pg8::gemm_phase<EpiPlain, pg8::StaticOrder, true>(C.lds, g, S, E, C.tid); }
            SEAM(); }
        if (IN(8)) { const Ctx C = fresh(CK);
            pg8::Gemm g{MERGEB, WB + WE_OUT, DM, DM, DM}; pg8::StaticOrder S; S.init(M, DM, C.G, C.bid);
            EpiResid<0> E{HB1, HB0, HSS + (size_t)(4 * L + 2) * M, 1.0f, nullptr, nullptr};
            pg8::gemm_phase<EpiResid<0>, pg8::StaticOrder, true>(C.lds, g, S, E, C.tid); SEAM(); }
        if (IN(9)) { const Ctx C = fresh(CK);
            pg8::Gemm g{HB0, WB + WE_13B, DM, DM, DM}; pg8::StaticOrder S; S.init(M, 2 * FF, C.G, C.bid);
            EpiSwiGLU E{HSS + (size_t)(4 * L + 2) * M, U};
            pg8::gemm_phase<EpiSwiGLU, pg8::StaticOrder, true>(C.lds, g, S, E, C.tid); SEAM(); }
        if (IN(10)) { const Ctx C = fresh(CK);
            pg8::Gemm g{U, WB + WE_2B, FF, FF, FF}; pg8::StaticOrder S; S.init(M, DM, C.G, C.bid);
            EpiResid<0> E{HB0, HB1, HSS + (size_t)(4 * L + 3) * M, 0.5f, nullptr, nullptr};
            pg8::gemm_phase<EpiResid<0>, pg8::StaticOrder, true>(C.lds, g, S, E, C.tid); SEAM(); }
        if (IN(11)) { const Ctx C = fresh(CK);
            pg8::Gemm g{HB1, WB + WE_PG, DM, DM, DM}; pg8::StaticOrder S; S.init(M, DM, C.G, C.bid);
            EpiResid<1> E{HB1, HB0, HSS + (size_t)(4 * L + 4) * M, 0.f, HSS + (size_t)(4 * L + 3) * M, PP};
            pg8::gemm_phase<EpiResid<1>, pg8::StaticOrder, true>(C.lds, g, S, E, C.tid); SEAM(); }
    }
    if (((MK_MASK >> 12) & 1) && P.l_hi == DEPTH && P.ph_hi > NPHASE) final_phase(P, CK);
#undef SEAM
#undef IN
#undef WSP
#undef WB
#undef H
#undef HB0
#undef HB1
#undef ZIN
#undef U
#undef SMALL
#undef Q
#undef KN
#undef V
#undef KR
#undef PP
#undef PB
#undef COS
#undef SIN
#undef MERGE
#undef MERGEB
#undef Y
#undef HSS
#undef CQSS
#undef CKVSS
#undef YBSS
}

extern "C" void kernel_launch(void* const* d_in, const int* in_sizes, int n_in, void* d_out, int out_size, void* d_ws, size_t ws_size, hipStream_t stream) {
    static int grid = 0;
    if (grid == 0) {
        if (n_in != 30 || in_sizes[0] != M * DM || out_size != M * DM || ws_size < WS_END) {
            fprintf(stderr, "kernel_launch: unexpected shapes: n_in %d in0 %d out %d ws %zu (need %zu)\n", n_in, n_in > 0 ? in_sizes[0] : -1, out_size, ws_size, (size_t)WS_END); grid = -1; return; }
        int dev = 0, cus = 0, per_cu = 0;
        if (hipGetDevice(&dev) != hipSuccess || hipDeviceGetAttribute(&cus, hipDeviceAttributeMultiprocessorCount, dev) != hipSuccess) { grid = -1; return; }
        if (hipFuncSetAttribute((const void*)mk_fwd, hipFuncAttributeMaxDynamicSharedMemorySize, LDS_BYTES) != hipSuccess) { fprintf(stderr, "kernel_launch: hipFuncSetAttribute failed\n"); grid = -1; return; }
        if (hipOccupancyMaxActiveBlocksPerMultiprocessor(&per_cu, (const void*)mk_fwd, 512, LDS_BYTES) != hipSuccess || per_cu < 1)
            fprintf(stderr, "kernel_launch: note: occupancy query reports %d workgroups per CU\n", per_cu);
        (void)hipGetLastError();
        grid = cus;
    }
    if (grid < 0) return;
    if (hipMemsetAsync((char*)d_ws + WS_CTL, 0, CTL_ZERO_BYTES, stream) != hipSuccess) return;
    Params p; memset(&p, 0, sizeof(p));
    for (int i = 0; i < 30; ++i) p.in[i] = (const float*)d_in[i];
    p.out = (float*)d_out; p.ws = (unsigned char*)d_ws;
#if MK_MODE == 0
    p.l_lo = 0; p.l_hi = DEPTH; p.ph_lo = 0; p.ph_hi = NPHASE + 1; p.use_bar = 1;
    hipLaunchKernelGGL(mk_fwd, dim3(grid), dim3(512), LDS_BYTES, stream, p);
#else
    p.use_bar = 0;
    for (int L = 0; L < DEPTH; ++L)
        for (int k = 0; k < NPHASE; ++k) { p.l_lo = L; p.l_hi = L + 1; p.ph_lo = k; p.ph_hi = k + 1;
            hipLaunchKernelGGL(mk_fwd, dim3(grid), dim3(512), LDS_BYTES, stream, p); }
    p.l_lo = DEPTH; p.l_hi = DEPTH; p.ph_lo = NPHASE; p.ph_hi = NPHASE + 1;
    hipLaunchKernelGGL(mk_fwd, dim3(grid), dim3(512), LDS_BYTES, stream, p);
#endif
    const hipError_t le = hipPeekAtLastError();
    if (le != hipSuccess) fprintf(stderr, "kernel_launch: launch failed: %s\n", hipGetErrorName(le));
}
```
